# Optimizing an MI355X kernel written in HIP

```python
import jax, jax.numpy as jnp
from jax import lax
import numpy as np

D_MODEL = 1024
BATCH = 2
SEQ = 8192
DEPTH = 1

ATT_HEADS = 8
ATT_KV_HEADS = 2
HEAD_DIM = 64
ATT_WIDTH = ATT_HEADS * HEAD_DIM
KV_WIDTH = ATT_KV_HEADS * HEAD_DIM
WINDOW = 128
ATT_BLOCK = 128
ROPE_DIM = HEAD_DIM // 4
ROPE_THETA = 500000.0
SSD_HEADS = 8
SSD_HEAD_DIM = 64
SSD_WIDTH = SSD_HEADS * SSD_HEAD_DIM
SSD_GROUPS = 2
SSD_STATE = 128
CONV_K = 4
CHUNK = 128
XBC_WIDTH = SSD_WIDTH + 2 * SSD_GROUPS * SSD_STATE
MIX_WIDTH = ATT_WIDTH + SSD_WIDTH
IN_WIDTH = ATT_WIDTH + 2 * KV_WIDTH + SSD_WIDTH + XBC_WIDTH + SSD_HEADS
N_GROUPS = 4
EXPERTS_PER_GROUP = 8
N_EXPERTS = N_GROUPS * EXPERTS_PER_GROUP
TOP_K = 2
D_EXPERT = 256
EPS = 1e-6

kernel_name = "hymba_ssd_swa_sink_hmoe_adaln_layer"


def rms_norm(x, w):
    xf = x.astype(jnp.float32)
    y = xf * lax.rsqrt(jnp.mean(xf * xf, axis=-1, keepdims=True) + EPS)
    return (y * w.astype(jnp.float32)).astype(x.dtype)


def partial_rope(x, positions):
    half = ROPE_DIM // 2
    inv_freq = jnp.power(ROPE_THETA, -jnp.arange(half, dtype=jnp.float32) * 2.0 / ROPE_DIM)
    ang = positions.astype(jnp.float32)[..., None] * inv_freq
    cos = jnp.cos(ang)[:, :, None, :]
    sin = jnp.sin(ang)[:, :, None, :]
    xr = x[..., :ROPE_DIM].astype(jnp.float32)
    x1, x2 = xr[..., :half], xr[..., half:]
    rot = jnp.concatenate([x1 * cos - x2 * sin, x2 * cos + x1 * sin], axis=-1).astype(x.dtype)
    return jnp.concatenate([rot, x[..., ROPE_DIM:]], axis=-1)


def sliding_window_attention(q, k, v, sinks):
    b, s = q.shape[:2]
    nb = s // ATT_BLOCK
    grp = ATT_HEADS // ATT_KV_HEADS
    qb = q.reshape(b, nb, ATT_BLOCK, ATT_KV_HEADS, grp, HEAD_DIM)

    def band(t):
        tb = t.reshape(b, nb, ATT_BLOCK, ATT_KV_HEADS, HEAD_DIM)
        prev = jnp.pad(tb[:, :-1], ((0, 0), (1, 0), (0, 0), (0, 0), (0, 0)))
        return jnp.concatenate([prev, tb], axis=2)

    kb, vb = band(k), band(v)
    scores = jnp.einsum('bnqkgd,bnskd->bnkgqs', qb, kb).astype(jnp.float32) * (HEAD_DIM ** -0.5)
    qi = jnp.arange(ATT_BLOCK)[:, None]
    si = jnp.arange(2 * ATT_BLOCK)[None, :]
    diff = qi + ATT_BLOCK - si
    band_mask = (diff >= 0) & (diff < WINDOW)
    blk = jnp.arange(nb)[:, None, None]
    valid = band_mask[None] & ((blk > 0) | (si[None] >= ATT_BLOCK))
    scores = jnp.where(valid[None, :, None, None], scores, -jnp.inf)
    sink = sinks.astype(jnp.float32).reshape(ATT_KV_HEADS, grp)[None, None, :, :, None, None]
    m = jnp.maximum(jnp.max(scores, axis=-1, keepdims=True), sink)
    p = jnp.exp(scores - m)
    probs = (p / (jnp.sum(p, axis=-1, keepdims=True) + jnp.exp(sink - m))).astype(v.dtype)
    out = jnp.einsum('bnkgqs,bnskd->bnqkgd', probs, vb)
    return out.reshape(b, s, ATT_WIDTH)


def causal_depthwise_conv(x, w, bias):
    ch = x.shape[-1]
    y = lax.conv_general_dilated(x, w[:, None, :], window_strides=(1,),
                                 padding=[(CONV_K - 1, 0)],
                                 dimension_numbers=('NWC', 'WIO', 'NWC'),
                                 feature_group_count=ch)
    return y + bias


def ssd_scan(x, dt, A, B, C):
    b, s, h, p = x.shape
    n = B.shape[-1]
    nc = s // CHUNK
    hpg = h // SSD_GROUPS
    f32 = jnp.float32
    xdt = (x.astype(f32) * dt[..., None]).reshape(b, nc, CHUNK, h, p)
    a = (dt * A).reshape(b, nc, CHUNK, h)
    a_cum = jnp.cumsum(a, axis=2)
    Bc = B.astype(f32).reshape(b, nc, CHUNK, SSD_GROUPS, n)
    Cc = C.astype(f32).reshape(b, nc, CHUNK, SSD_GROUPS, n)
    seg = a_cum[:, :, :, None, :] - a_cum[:, :, None, :, :]
    causal = jnp.tril(jnp.ones((CHUNK, CHUNK), dtype=bool))
    decay = jnp.exp(jnp.where(causal[None, None, :, :, None], seg, -jnp.inf))
    cb = jnp.repeat(jnp.einsum('bclgn,bcsgn->bclsg', Cc, Bc), hpg, axis=-1)
    y_diag = jnp.einsum('bclsh,bcshp->bclhp', cb * decay, xdt)
    B_h = jnp.repeat(Bc, hpg, axis=3)
    decay_to_end = jnp.exp(a_cum[:, :, -1:, :] - a_cum)
    states = jnp.einsum('bclhn,bclh,bclhp->bchpn', B_h, decay_to_end, xdt)
    chunk_decay = jnp.exp(a_cum[:, :, -1, :])

    def step(carry, inp):
        st, dec = inp
        return carry * dec[:, :, None, None] + st, carry

    init = jnp.zeros((b, h, p, n), f32)
    _, prev = lax.scan(step, init, (jnp.moveaxis(states, 1, 0), jnp.moveaxis(chunk_decay, 1, 0)))
    prev = jnp.moveaxis(prev, 0, 1)
    C_h = jnp.repeat(Cc, hpg, axis=3)
    y_off = jnp.einsum('bclhn,bchpn,bclh->bclhp', C_h, prev, jnp.exp(a_cum))
    return (y_diag + y_off).reshape(b, s, h, p).astype(x.dtype)


def hybrid_mixer(h, positions, w_in, conv_w, conv_b, dt_bias, a_log, d_skip, ssd_norm_w,
                 q_norm_w, k_norm_w, sinks, w_out):
    b, s, _ = h.shape
    proj = h @ w_in
    cuts = [ATT_WIDTH, ATT_WIDTH + KV_WIDTH, ATT_WIDTH + 2 * KV_WIDTH,
            ATT_WIDTH + 2 * KV_WIDTH + SSD_WIDTH,
            ATT_WIDTH + 2 * KV_WIDTH + SSD_WIDTH + XBC_WIDTH]
    q, k, v, z, xbc, dt = jnp.split(proj, cuts, axis=-1)
    q = partial_rope(rms_norm(q.reshape(b, s, ATT_HEADS, HEAD_DIM), q_norm_w), positions)
    k = partial_rope(rms_norm(k.reshape(b, s, ATT_KV_HEADS, HEAD_DIM), k_norm_w), positions)
    v = v.reshape(b, s, ATT_KV_HEADS, HEAD_DIM)
    att = sliding_window_attention(q, k, v, sinks)
    xbc = jax.nn.silu(causal_depthwise_conv(xbc, conv_w, conv_b))
    xs, Bm, Cm = jnp.split(xbc, [SSD_WIDTH, SSD_WIDTH + SSD_GROUPS * SSD_STATE], axis=-1)
    xs = xs.reshape(b, s, SSD_HEADS, SSD_HEAD_DIM)
    Bm = Bm.reshape(b, s, SSD_GROUPS, SSD_STATE)
    Cm = Cm.reshape(b, s, SSD_GROUPS, SSD_STATE)
    dt = jax.nn.softplus(dt.astype(jnp.float32) + dt_bias.astype(jnp.float32))
    A = -jnp.exp(a_log.astype(jnp.float32))
    y = ssd_scan(xs, dt, A, Bm, Cm) + d_skip[:, None] * xs
    y = y.reshape(b, s, SSD_WIDTH) * jax.nn.silu(z)
    y = rms_norm(y.reshape(b, s, SSD_GROUPS, SSD_WIDTH // SSD_GROUPS),
                 ssd_norm_w.reshape(SSD_GROUPS, SSD_WIDTH // SSD_GROUPS)).reshape(b, s, SSD_WIDTH)
    return jnp.concatenate([att, y], axis=-1) @ w_out


def hierarchical_moe(h, w_group, b_group, w_expert, b_expert, w_gate, w_up, w_down):
    b, s, d = h.shape
    t = h.reshape(b * s, d)
    g_probs = jax.nn.softmax((t @ w_group + b_group).astype(jnp.float32), axis=-1)
    g_p, g_idx = lax.top_k(g_probs, 1)
    e_logits = (t @ w_expert + b_expert).astype(jnp.float32).reshape(-1, N_GROUPS, EXPERTS_PER_GROUP)
    e_sel = jnp.take_along_axis(e_logits, g_idx[:, :, None], axis=1)[:, 0]
    e_p, e_idx = lax.top_k(jax.nn.softmax(e_sel, axis=-1), TOP_K)
    e_p = e_p / jnp.sum(e_p, axis=-1, keepdims=True)
    group_w = jax.nn.one_hot(g_idx[:, 0], N_GROUPS, dtype=jnp.float32) * g_p
    exp_w = jnp.einsum('tk,tke->te', e_p, jax.nn.one_hot(e_idx, EXPERTS_PER_GROUP, dtype=jnp.float32))
    combine = (group_w[:, :, None] * exp_w[:, None, :]).reshape(-1, N_EXPERTS).astype(h.dtype)
    hg = jnp.einsum('td,edf->tef', t, w_gate)
    hu = jnp.einsum('td,edf->tef', t, w_up)
    act = jax.nn.silu(hg) * hu * combine[:, :, None]
    y = jnp.einsum('tef,efd->td', act, w_down)
    return y.reshape(b, s, d)


def setup_inputs(seed: int = 0) -> dict:
    key = jax.random.key(seed)
    ks = jax.random.split(key, 26)
    f32 = jnp.float32
    nrm = lambda k, shape, scale: jax.random.normal(k, shape, f32) * scale
    dt0 = jnp.exp(jax.random.uniform(ks[9], (SSD_HEADS,), f32, np.log(1e-3), np.log(1e-1)))
    return {
        "x": nrm(ks[0], (BATCH, SEQ, D_MODEL), 1.0),
        "c": nrm(ks[1], (BATCH, D_MODEL), 1.0),
        "positions": jnp.broadcast_to(jnp.arange(SEQ, dtype=jnp.int32)[None, :], (BATCH, SEQ)),
        "norm1_w": 1.0 + nrm(ks[2], (D_MODEL,), 0.02),
        "norm2_w": 1.0 + nrm(ks[3], (D_MODEL,), 0.02),
        "w_ada": nrm(ks[4], (D_MODEL, 6 * D_MODEL), 0.5 * D_MODEL ** -0.5),
        "b_ada": nrm(ks[5], (6 * D_MODEL,), 0.02),
        "w_in": nrm(ks[6], (D_MODEL, IN_WIDTH), D_MODEL ** -0.5),
        "conv_w": nrm(ks[7], (CONV_K, XBC_WIDTH), CONV_K ** -0.5),
        "conv_b": nrm(ks[8], (XBC_WIDTH,), 0.02),
        "dt_bias": dt0 + jnp.log(-jnp.expm1(-dt0)),
        "a_log": jnp.log(jax.random.uniform(ks[10], (SSD_HEADS,), f32, 1.0, 16.0)),
        "d_skip": 1.0 + nrm(ks[11], (SSD_HEADS,), 0.1),
        "ssd_norm_w": 1.0 + nrm(ks[12], (SSD_WIDTH,), 0.02),
        "q_norm_w": 1.0 + nrm(ks[13], (HEAD_DIM,), 0.02),
        "k_norm_w": 1.0 + nrm(ks[14], (HEAD_DIM,), 0.02),
        "sinks": nrm(ks[15], (ATT_HEADS,), 0.5),
        "w_out": nrm(ks[16], (MIX_WIDTH, D_MODEL), MIX_WIDTH ** -0.5),
        "w_group": nrm(ks[17], (D_MODEL, N_GROUPS), D_MODEL ** -0.5),
        "b_group": nrm(ks[18], (N_GROUPS,), 0.01),
        "w_expert": nrm(ks[19], (D_MODEL, N_EXPERTS), D_MODEL ** -0.5),
        "b_expert": nrm(ks[20], (N_EXPERTS,), 0.01),
        "w_gate": nrm(ks[21], (N_EXPERTS, D_MODEL, D_EXPERT), D_MODEL ** -0.5),
        "w_up": nrm(ks[22], (N_EXPERTS, D_MODEL, D_EXPERT), D_MODEL ** -0.5),
        "w_down": nrm(ks[23], (N_EXPERTS, D_EXPERT, D_MODEL), D_EXPERT ** -0.5),
    }


def reference(x, c, positions, norm1_w, norm2_w, w_ada, b_ada, w_in, conv_w, conv_b,
              dt_bias, a_log, d_skip, ssd_norm_w, q_norm_w, k_norm_w, sinks, w_out,
              w_group, b_group, w_expert, b_expert, w_gate, w_up, w_down):
    mod = jax.nn.silu(c) @ w_ada + b_ada
    shift1, scale1, gate1, shift2, scale2, gate2 = [m[:, None, :] for m in jnp.split(mod, 6, axis=-1)]
    for _ in range(DEPTH):
        h = rms_norm(x, norm1_w) * (1.0 + scale1) + shift1
        x = x + gate1 * hybrid_mixer(h, positions, w_in, conv_w, conv_b, dt_bias, a_log, d_skip,
                                     ssd_norm_w, q_norm_w, k_norm_w, sinks, w_out)
        h = rms_norm(x, norm2_w) * (1.0 + scale2) + shift2
        x = x + gate2 * hierarchical_moe(h, w_group, b_group, w_expert, b_expert, w_gate, w_up, w_down)
    return x
```

```cpp
#include <hip/hip_runtime.h>
#include <cstdio>
#include <cstdint>
#include <cmath>
namespace pg8 {
#define PG8_LAS __attribute__((address_space(3)))
typedef unsigned short bf16_t;
typedef short bf16x8 __attribute__((ext_vector_type(8)));
typedef float f32x4 __attribute__((ext_vector_type(4)));
typedef unsigned u32x4 __attribute__((ext_vector_type(4)));
constexpr int BM = 256, BK = 64, HALF = 128, HTB = HALF * BK * 2  , STAGE_BYTES = 8 * HTB, NXCD = 8, WGM = 8;

__host__ __device__ __forceinline__ int lds_byte(int r, int c) { const int st = (r >> 4) * 2 + (c >> 5), rr = r & 15, cc = c & 31, ob = rr * 64 + cc * 2; return st * 1024 + (ob ^ (((ob >> 9) & 1) << 5)); }
__host__ __device__ __forceinline__ void stage_rc(int b, int& R, int& C) { const int st = b / 1024, sb = b % 1024, swz = sb ^ (((sb >> 9) & 1) << 5); R = (st >> 1) * 16 + swz / 64; C = (st & 1) * 32 + (swz % 64) / 2; }
__host__ __device__ __forceinline__ int perm32(int rho) { const int n = rho >> 4, i = rho & 15; return 8 * (i >> 2) + 4 * n + (i & 3); }

struct Unit { int pm, pn; };
struct Gemm { const bf16_t* A; const bf16_t* Bt; int M, N, K; const int* gather; int nvalid; };

struct StaticOrder {
    int nM, nN, nwg, G, c;
    __host__ __device__ void init(int M, int N, int G_, int c_) { nM = M / BM; nN = N / BM; nwg = nM * nN; G = G_; c = c_; }
    __host__ __device__ bool next(int i, Unit& u) const {
        const long L = (long)i * G + c; if (L >= nwg) return false;
        int wgid = (int)L; { const int q = nwg / NXCD, r = nwg % NXCD, xcd = wgid % NXCD, off = wgid / NXCD; wgid = (xcd < r ? xcd * (q + 1) : r * (q + 1) + (xcd - r) * q) + off; }
        const int nig = WGM * nN, gid = wgid / nig, fm = gid * WGM, gsz = (nM - fm) < WGM ? (nM - fm) : WGM;
        u.pm = fm + ((wgid % nig) % gsz); u.pn = (wgid % nig) / gsz; return true;
    }
    __device__ __forceinline__ void a_ready(const Unit&) const {}
    __device__ __forceinline__ void done(const Unit&) const {}
};


__device__ __forceinline__ unsigned cvt_pk_bf16(float lo, float hi) { typedef float f2_t __attribute__((ext_vector_type(2))); typedef __bf16 b2_t __attribute__((ext_vector_type(2))); f2_t v = {lo, hi}; b2_t b = __builtin_convertvector(v, b2_t); return __builtin_bit_cast(unsigned, b); }
__device__ __forceinline__ float silu_f(float v) { return v * __builtin_amdgcn_rcpf(1.0f + __builtin_amdgcn_exp2f(-1.4426950408889634f * v)); }

struct SingleUnit {
    int pm, pn;
    __device__ __forceinline__ bool next(int i, Unit& u) const { if (i != 0) return false; u.pm = pm; u.pn = pn; return true; }
    __device__ __forceinline__ void a_ready(const Unit&) const {}
    __device__ __forceinline__ void done(const Unit&) const {}
};

struct EpiBf16 {
    static constexpr bool PERM = true, AFTER_DRAIN = false;
    bf16_t* O; int ldc;
    __device__ __forceinline__ void operator()(const f32x4 (&acc)[2][2][4][2], const Unit& u, int wr, int wc, int fr, int fq) const {
        const int row0 = u.pm * BM + wr * 64 + fr, col0 = u.pn * BM + wc * 32 + 8 * fq;
#pragma unroll
        for (int ai = 0; ai < 2; ++ai)
#pragma unroll
            for (int m = 0; m < 4; ++m) { bf16_t* rowp = O + (size_t)(row0 + ai * HALF + m * 16) * ldc + col0;
#pragma unroll
                for (int bj = 0; bj < 2; ++bj) { const f32x4 v0 = acc[ai][bj][m][0], v1 = acc[ai][bj][m][1];
                    u32x4 w; w.x = cvt_pk_bf16(v0[0], v0[1]); w.y = cvt_pk_bf16(v0[2], v0[3]); w.z = cvt_pk_bf16(v1[0], v1[1]); w.w = cvt_pk_bf16(v1[2], v1[3]);
                    *(u32x4*)(rowp + bj * HALF) = w; } }
    }
};
struct EpiResGate {
    static constexpr bool PERM = false, AFTER_DRAIN = false;
    const float* x; float* out; const float* gate; int gpitch; int rows_per_batch;
    __device__ __forceinline__ void operator()(const f32x4 (&acc)[2][2][4][2], const Unit& u, int wr, int wc, int fr, int fq) const {
        const int b = (u.pm * BM) / rows_per_batch; const float* gp = gate + (size_t)b * gpitch;
        const int col0 = u.pn * BM + wc * 32 + 4 * fq;
        f32x4 gv[2][2];
#pragma unroll
        for (int bj = 0; bj < 2; ++bj)
#pragma unroll
            for (int n = 0; n < 2; ++n) gv[bj][n] = *(const f32x4*)(gp + col0 + bj * HALF + n * 16);
#pragma unroll
        for (int ai = 0; ai < 2; ++ai)
#pragma unroll
            for (int m = 0; m < 4; ++m) { const size_t off = (size_t)(u.pm * BM + ai * HALF + wr * 64 + m * 16 + fr) * 1024 + col0;
#pragma unroll
                for (int bj = 0; bj < 2; ++bj)
#pragma unroll
                    for (int n = 0; n < 2; ++n) { const f32x4 xv = *(const f32x4*)(x + off + bj * HALF + n * 16); *(f32x4*)(out + off + bj * HALF + n * 16) = xv + gv[bj][n] * acc[ai][bj][m][n]; } }
    }
};
struct EpiAct {
    static constexpr bool PERM = true, AFTER_DRAIN = false;
    bf16_t* O;
    __device__ __forceinline__ void operator()(const f32x4 (&acc)[2][2][4][2], const Unit& u, int wr, int wc, int fr, int fq) const {
        const int col0 = wc * 32 + 8 * fq;
#pragma unroll
        for (int ai = 0; ai < 2; ++ai)
#pragma unroll
            for (int m = 0; m < 4; ++m) { const int rl = ai * HALF + wr * 64 + m * 16 + fr;
                float a[8];
#pragma unroll
                for (int n = 0; n < 2; ++n)
#pragma unroll
                    for (int i = 0; i < 4; ++i) a[4 * n + i] = silu_f(acc[ai][0][m][n][i]) * acc[ai][1][m][n][i];
                u32x4 w; w.x = cvt_pk_bf16(a[0], a[1]); w.y = cvt_pk_bf16(a[2], a[3]); w.z = cvt_pk_bf16(a[4], a[5]); w.w = cvt_pk_bf16(a[6], a[7]);
                *(u32x4*)(O + (size_t)rl * 256 + col0) = w; asm volatile("" ::: "memory"); }
    }
};
struct EpiDown {
    static constexpr bool PERM = false, AFTER_DRAIN = false;
    const int* toks; int nvalid; const float* cw; int slot; const float* gate2; int gpitch; int rows_per_batch; float* out;
    __device__ __forceinline__ void operator()(const f32x4 (&acc)[2][2][4][2], const Unit& u, int wr, int wc, int fr, int fq) const {
        const int col0 = (u.pn & 3) * BM + wc * 32 + 4 * fq;
#pragma unroll
        for (int ai = 0; ai < 2; ++ai)
#pragma unroll
            for (int m = 0; m < 4; ++m) { const int rl = ai * HALF + wr * 64 + m * 16 + fr;
                if (rl < nvalid) { const int tok = toks[rl]; const float w = cw[tok * 2 + slot]; const float* gp = gate2 + (size_t)(tok / rows_per_batch) * gpitch; float* op = out + (size_t)tok * 1024;
#pragma unroll
                    for (int bj = 0; bj < 2; ++bj) {
#pragma unroll
                        for (int n = 0; n < 2; ++n) { const int c = col0 + bj * HALF + n * 16; const f32x4 gv = *(const f32x4*)(gp + c); const f32x4 o = *(const f32x4*)(op + c);
                            *(f32x4*)(op + c) = o + (gv * w) * acc[ai][bj][m][n]; }
                        asm volatile("" ::: "memory"); } }
                asm volatile("" ::: "memory"); }
    }
};

template <class Epi, class Sched, bool ALIGN_EPI = false, bool SP2 = false, bool GATHER = false>
__device__ __forceinline__ void gemm_phase(PG8_LAS unsigned char* lds, const Gemm g, const Sched& S, const Epi& E) {
    const int tid = threadIdx.x, wid = __builtin_amdgcn_readfirstlane(tid >> 6), lane = tid & 63, wr = wid >> 2, wc = wid & 3, fr = lane & 15, fq = lane >> 4;
    const int K = g.K, nt = K / BK;
    unsigned voffA[2], voffA1[2], voffB[2];
#pragma unroll
    for (int i = 0; i < 2; ++i) { int R, C; stage_rc(tid * 16 + i * 8192, R, C); const int Rb = Epi::PERM ? ((R & ~31) + perm32(R & 31)) : R;
        voffB[i] = (unsigned)(Rb * K + C) * 2u;
        if constexpr (GATHER) { const int t0 = (R < g.nvalid) ? g.gather[R] : g.gather[0]; const int t1 = (R + HALF < g.nvalid) ? g.gather[R + HALF] : g.gather[0];
            voffA[i] = (unsigned)(t0 * K + C) * 2u; voffA1[i] = (unsigned)(t1 * K + C) * 2u; }
        else { voffA[i] = (unsigned)(R * K + C) * 2u; voffA1[i] = voffA[i]; } }
    const size_t kstep = (size_t)(BK * 2);
    const size_t hstep = (size_t)HALF * K * 2;
    const size_t tstep = 2 * hstep;
    const size_t hstepA = GATHER ? (size_t)0 : hstep;
    const unsigned ldsw = (unsigned)wid * 1024u;
    const int aoff = lds_byte(wr * 64 + fr, fq * 8), boff = lds_byte(wc * 32 + fr, fq * 8);
#define PG8_SA(b, h) (((b) * 2 + (h)) * HTB)
#define PG8_SB(b, h) ((4 + (b) * 2 + (h)) * HTB)
#define PG8_STAGE(bufoff, gbase, voff) do { _Pragma("unroll") for (int _i = 0; _i < 2; ++_i) \
        __builtin_amdgcn_global_load_lds((const unsigned*)((const char*)(gbase) + (voff)[_i]), (PG8_LAS unsigned*)(lds + (bufoff) + ldsw + _i * 8192), 16, 0, 0); } while (0)
#define PG8_LDA(dst, b, h) do { _Pragma("unroll") for (int m = 0; m < 4; ++m) _Pragma("unroll") for (int k = 0; k < 2; ++k) dst[m][k] = *(const PG8_LAS bf16x8*)(lds + PG8_SA(b, h) + aoff + m * 2048 + k * 1024); } while (0)
#define PG8_LDB(dst, b, h) do { _Pragma("unroll") for (int n = 0; n < 2; ++n) _Pragma("unroll") for (int k = 0; k < 2; ++k) dst[n][k] = *(const PG8_LAS bf16x8*)(lds + PG8_SB(b, h) + boff + n * 2048 + k * 1024); } while (0)
#define PG8_MMA(ai, bj, At, Bt) do { __builtin_amdgcn_s_setprio(1); _Pragma("unroll") for (int m = 0; m < 4; ++m) _Pragma("unroll") for (int n = 0; n < 2; ++n) _Pragma("unroll") for (int k = 0; k < 2; ++k) \
        acc[ai][bj][m][n] = __builtin_amdgcn_mfma_f32_16x16x32_bf16(Bt[n][k], At[m][k], acc[ai][bj][m][n], 0, 0, 0); __builtin_amdgcn_s_setprio(0); } while (0)
#define PG8_WAIT_V(n) asm volatile("s_waitcnt vmcnt(" #n ")" ::: "memory")
#define PG8_WAIT_L(n) asm volatile("s_waitcnt lgkmcnt(" #n ")" ::: "memory")
#define PG8_BAR __builtin_amdgcn_s_barrier()
#define PG8_SCHED __builtin_amdgcn_sched_barrier(0)
    Unit cur, nxt; int ui = 0;
    if (!S.next(0, cur)) return;
    f32x4 acc[2][2][4][2];
#pragma unroll
    for (int a = 0; a < 2; ++a)
#pragma unroll
        for (int b = 0; b < 2; ++b)
#pragma unroll
            for (int m = 0; m < 4; ++m)
#pragma unroll
                for (int n = 0; n < 2; ++n) acc[a][b][m][n] = (f32x4){0.f, 0.f, 0.f, 0.f};
    bf16x8 At[4][2], B0[2][2], B1[2][2];
    const char* cA = (const char*)g.A + (size_t)cur.pm * tstep; const char* cB = (const char*)g.Bt + (size_t)cur.pn * tstep;
    S.a_ready(cur);
    if constexpr (SP2) {
        PG8_STAGE(PG8_SB(0, 0), cB, voffB); PG8_STAGE(PG8_SB(0, 1), cB + hstep, voffB); PG8_STAGE(PG8_SA(0, 0), cA, voffA); PG8_STAGE(PG8_SA(0, 1), cA + hstepA, voffA1);
        if (wr == 1) PG8_BAR;
        PG8_WAIT_V(2); PG8_BAR;
        PG8_STAGE(PG8_SB(1, 0), cB + kstep, voffB); PG8_STAGE(PG8_SA(1, 0), cA + kstep, voffA); PG8_STAGE(PG8_SB(1, 1), cB + hstep + kstep, voffB);
        PG8_WAIT_V(6); PG8_BAR;
    } else {
        PG8_STAGE(PG8_SB(0, 0), cB, voffB); PG8_STAGE(PG8_SA(0, 0), cA, voffA); PG8_STAGE(PG8_SB(0, 1), cB + hstep, voffB); PG8_STAGE(PG8_SA(0, 1), cA + hstepA, voffA1);
        if (wr == 1) PG8_BAR;
        PG8_WAIT_V(4); PG8_BAR;
        PG8_STAGE(PG8_SB(1, 0), cB + kstep, voffB); PG8_STAGE(PG8_SA(1, 0), cA + kstep, voffA); PG8_STAGE(PG8_SB(1, 1), cB + hstep + kstep, voffB);
        PG8_WAIT_V(6); PG8_BAR;
    }
    for (;;) {
        const bool has_next = S.next(ui + 1, nxt);
        const char* nA = has_next ? (const char*)g.A + (size_t)nxt.pm * tstep : cA; const char* nB = has_next ? (const char*)g.Bt + (size_t)nxt.pn * tstep : cB;
#pragma unroll 1
        for (int t = 0; t < nt; t += 2) {
            const bool last = (t == nt - 2);
            const char* a1 = cA + (size_t)(t + 1) * kstep;
            const char* a2 = last ? nA : cA + (size_t)(t + 2) * kstep; const char* b2 = last ? nB : cB + (size_t)(t + 2) * kstep;
            const char* a3 = a2 + kstep; const char* b3 = b2 + kstep;
            if (last && has_next) S.a_ready(nxt);
            if constexpr (SP2) {
            PG8_LDB(B0, 0, 0); PG8_LDB(B1, 0, 1); PG8_SCHED; PG8_LDA(At, 0, 0); PG8_STAGE(PG8_SA(1, 1), a1 + hstepA, voffA1);
            PG8_WAIT_V(8); PG8_WAIT_L(0); PG8_BAR; PG8_MMA(0, 0, At, B0); PG8_MMA(0, 1, At, B1); PG8_BAR; PG8_SCHED;
            PG8_LDA(At, 0, 1); PG8_STAGE(PG8_SB(0, 0), b2, voffB); PG8_STAGE(PG8_SB(0, 1), b2 + hstep, voffB); PG8_STAGE(PG8_SA(0, 0), a2, voffA);
            PG8_WAIT_V(8); PG8_WAIT_L(0); PG8_BAR; PG8_MMA(1, 0, At, B0); PG8_MMA(1, 1, At, B1); PG8_BAR; PG8_SCHED;
            PG8_LDB(B0, 1, 0); PG8_LDB(B1, 1, 1); PG8_SCHED; PG8_LDA(At, 1, 0); PG8_STAGE(PG8_SA(0, 1), a2 + hstepA, voffA1);
            PG8_WAIT_V(8); PG8_WAIT_L(0); PG8_BAR; PG8_MMA(0, 0, At, B0); PG8_MMA(0, 1, At, B1); PG8_BAR; PG8_SCHED;
            PG8_LDA(At, 1, 1); PG8_STAGE(PG8_SB(1, 0), b3, voffB); PG8_STAGE(PG8_SB(1, 1), b3 + hstep, voffB); PG8_STAGE(PG8_SA(1, 0), a3, voffA);
            PG8_WAIT_V(8); PG8_WAIT_L(0); PG8_BAR; PG8_MMA(1, 0, At, B0); PG8_MMA(1, 1, At, B1); PG8_BAR; PG8_SCHED;
            } else {
            PG8_LDB(B0, 0, 0); PG8_SCHED; PG8_LDA(At, 0, 0); PG8_STAGE(PG8_SA(1, 1), a1 + hstepA, voffA1);
            PG8_WAIT_L(8); PG8_BAR; PG8_WAIT_L(0); PG8_MMA(0, 0, At, B0); PG8_BAR; PG8_SCHED;
            PG8_LDB(B1, 0, 1); PG8_STAGE(PG8_SB(0, 0), b2, voffB);
            PG8_BAR; PG8_WAIT_L(0); PG8_MMA(0, 1, At, B1); PG8_BAR;
            PG8_LDA(At, 0, 1); PG8_STAGE(PG8_SA(0, 0), a2, voffA);
            PG8_BAR; PG8_WAIT_L(0); PG8_MMA(1, 0, At, B0); PG8_BAR; PG8_SCHED;
            PG8_STAGE(PG8_SB(0, 1), b2 + hstep, voffB);
            PG8_WAIT_V(6); PG8_BAR; PG8_MMA(1, 1, At, B1); PG8_BAR;
            PG8_LDB(B0, 1, 0); PG8_SCHED; PG8_LDA(At, 1, 0); PG8_STAGE(PG8_SA(0, 1), a2 + hstepA, voffA1);
            PG8_WAIT_L(8); PG8_BAR; PG8_WAIT_L(0); PG8_MMA(0, 0, At, B0); PG8_BAR; PG8_SCHED;
            PG8_LDB(B1, 1, 1); PG8_STAGE(PG8_SB(1, 0), b3, voffB);
            PG8_BAR; PG8_WAIT_L(0); PG8_MMA(0, 1, At, B1); PG8_BAR;
            PG8_LDA(At, 1, 1); PG8_STAGE(PG8_SA(1, 0), a3, voffA);
            PG8_BAR; PG8_WAIT_L(0); PG8_MMA(1, 0, At, B0); PG8_BAR; PG8_SCHED;
            PG8_STAGE(PG8_SB(1, 1), b3 + hstep, voffB);
            PG8_WAIT_V(6); PG8_BAR; PG8_MMA(1, 1, At, B1); PG8_BAR;
            }
        }
        if constexpr (ALIGN_EPI) { if (wr == 0) PG8_BAR; }
        if constexpr (!Epi::AFTER_DRAIN) { E(acc, cur, wr, wc, fr, fq); S.done(cur); }
        if (!has_next) break;
#pragma unroll
        for (int a = 0; a < 2; ++a)
#pragma unroll
            for (int b = 0; b < 2; ++b)
#pragma unroll
                for (int m = 0; m < 4; ++m)
#pragma unroll
                    for (int n = 0; n < 2; ++n) acc[a][b][m][n] = (f32x4){0.f, 0.f, 0.f, 0.f};
        cur = nxt; cA = nA; cB = nB; ++ui;
        if constexpr (ALIGN_EPI) { if (wr == 1) PG8_BAR; }
    }
    PG8_WAIT_V(0);
    if constexpr (!ALIGN_EPI) { if (wr == 0) PG8_BAR; }
    PG8_BAR;
    if constexpr (Epi::AFTER_DRAIN) { E.fused(acc, cur, wr, wc, fr, fq, lds, wid, lane); S.done(cur); }
#undef PG8_SA
#undef PG8_SB
#undef PG8_STAGE
#undef PG8_LDA
#undef PG8_LDB
#undef PG8_MMA
#undef PG8_WAIT_V
#undef PG8_WAIT_L
#undef PG8_BAR
#undef PG8_SCHED
}
}

constexpr int BATCH = 2, SEQ = 8192, DM = 1024, M = BATCH * SEQ;
constexpr int INW = 2312, NPROJ = 2304;
constexpr int C_Q = 0, C_K = 512, C_V = 640, C_Z = 768, C_XBC = 1280;
constexpr int NEXP = 32, DEXP = 256, TOKCAP = 16384;
constexpr int MODW = 6 * DM;
constexpr float EPS = 1e-6f;
constexpr int NWAVES = 8;

constexpr size_t MiB = 1u << 20;
constexpr size_t WS_CTL = 0, CTL_ZERO_BYTES = 1 * MiB;
constexpr size_t WS_MODP = 1 * MiB;
constexpr size_t WS_MOD = WS_MODP + 512 * 1024;
constexpr size_t WS_ROPE = 2 * MiB;
constexpr size_t WS_DTRAW = 3 * MiB;
constexpr size_t WS_CHDEC = 3 * MiB + 512 * 1024;
constexpr size_t WS_CW = 4 * MiB;
constexpr size_t WS_WRT = 4 * MiB + 512 * 1024;
constexpr size_t WS_WIN = 6 * MiB;
constexpr size_t WS_WOUT = 11 * MiB;
constexpr size_t WS_WGU = 13 * MiB;
constexpr size_t WS_WD = 45 * MiB;
constexpr size_t WS_XN = 61 * MiB;
constexpr size_t WS_PROJ = 93 * MiB;
constexpr size_t WS_ACT = 93 * MiB;
constexpr size_t WS_STATES = 165 * MiB;
constexpr size_t WS_PREV = 197 * MiB;
constexpr size_t WS_MIX = 213 * MiB;
constexpr size_t WS_TOK = 245 * MiB;
constexpr size_t WS_END = 249 * MiB;
constexpr int CW_TMO = 0, CW_CODE = 1, CW_BAR = 4096, CW_CNT = 8192;

constexpr int RING_BYTES = 131072;
constexpr int LDSCTL_OFF = RING_BYTES, MISC_OFF = LDSCTL_OFF + 320;
constexpr int LDS_BYTES = 147456;

#define GAS __attribute__((address_space(1)))
#define LAS __attribute__((address_space(3)))
typedef unsigned short bf16;
typedef unsigned v4u __attribute__((ext_vector_type(4)));
typedef float f32x4 __attribute__((ext_vector_type(4)));
typedef short bf16x8 __attribute__((ext_vector_type(8)));
typedef GAS unsigned gu32;
typedef GAS unsigned long long gu64;
#define RLX_AGENT __ATOMIC_RELAXED, __HIP_MEMORY_SCOPE_AGENT
#define LDS_WAIT() asm volatile("s_waitcnt lgkmcnt(0)" ::: "memory")
#define VM_WAIT() asm volatile("s_waitcnt vmcnt(0)" ::: "memory")
__device__ __forceinline__ unsigned long long rt() { return __builtin_amdgcn_s_memrealtime(); }
__device__ __forceinline__ unsigned f2bf(float f) { unsigned u = __builtin_bit_cast(unsigned, f); return (u + 0x7fffu + ((u >> 16) & 1u)) >> 16; }
__device__ __forceinline__ unsigned pk2(float lo, float hi) { return f2bf(lo) | (f2bf(hi) << 16); }

#define XB_TMO      128
#define XB_XCNT(j)  (256  + 64 * (j))
#define XB_XSUB(j)  (1280 + 64 * (j))
#define XB_XGEN(j)  (2304 + 64 * (j))
#define XB_TOP      3328
#define XB_TOPGEN   3392
#define XCD_BAR_WORDS 3456
#define XB_SPIN_CAP (1u << 18)

__device__ __forceinline__ unsigned xb_ld(unsigned* p)              { return __hip_atomic_load(p, __ATOMIC_RELAXED, __HIP_MEMORY_SCOPE_AGENT); }
__device__ __forceinline__ unsigned xb_add(unsigned* p, unsigned v) { return __hip_atomic_fetch_add(p, v, __ATOMIC_RELAXED, __HIP_MEMORY_SCOPE_AGENT); }
__device__ __forceinline__ unsigned xb_xcc_id() { return (unsigned)__builtin_amdgcn_s_getreg((3 << 11) | 20) & 0xFu; }
#define XB_SPIN(cond, bar) do { unsigned _sp = 0; while (cond) { __builtin_amdgcn_s_sleep(1); \
    if ((++_sp & 255u) == 0u) { if (xb_ld(&(bar)[XB_TMO])) break; if (_sp > XB_SPIN_CAP) { atomicAdd(&(bar)[XB_TMO], 1u); break; } } } } while (0)

struct XcdBarrier {
    unsigned* bar; unsigned x;
    volatile LAS unsigned* st;
};

__device__ __forceinline__ XcdBarrier xcd_barrier_post(unsigned* bar, volatile LAS unsigned* st) {
    XcdBarrier b; b.bar = bar; b.x = xb_xcc_id(); b.st = st;
    if (threadIdx.x == 0) (void)xb_add(&bar[XB_XCNT(b.x)], 1u);
    return b;
}
__device__ __forceinline__ void xcd_barrier_complete(unsigned* bar, unsigned x, unsigned& nloc, unsigned& nx) {
    const unsigned G = gridDim.x * gridDim.y * gridDim.z;
    unsigned sum, cnt, mine, sp = 0u;
    for (;;) {
        sum = 0u; cnt = 0u; mine = 0u;
#pragma unroll
        for (unsigned j = 0; j < 16; ++j) { const unsigned c = xb_ld(&bar[XB_XCNT(j)]); sum += c; cnt += (c > 0u) ? 1u : 0u; mine = (j == x) ? c : mine; }
        if (sum == G) break;
        __builtin_amdgcn_s_sleep(1);
        if ((++sp & 255u) == 0u) { if (xb_ld(&bar[XB_TMO])) break; if (sp > XB_SPIN_CAP) { atomicAdd(&bar[XB_TMO], 1u); break; } }
    }
    nloc = mine > 0u ? mine : 1u; nx = cnt > 0u ? cnt : 1u;
}

__device__ __forceinline__ void xcd_barrier(const XcdBarrier& b) {
    asm volatile("s_waitcnt vmcnt(0)" ::: "memory");
    __syncthreads();
    if (threadIdx.x == 0) {
        unsigned* bar = b.bar;
        __builtin_amdgcn_s_waitcnt(0);
        unsigned nloc = b.st[0], nx = b.st[1];
        if (nloc == 0u) { xcd_barrier_complete(bar, b.x, nloc, nx); b.st[0] = nloc; b.st[1] = nx; }
        const unsigned old = xb_add(&bar[XB_XSUB(b.x)], 1u);
        const unsigned gen = old / nloc;
        if (old + 1u == (gen + 1u) * nloc) {
            __builtin_amdgcn_fence(__ATOMIC_RELEASE, "agent");
            asm volatile("s_waitcnt vmcnt(0)" ::: "memory");
            const unsigned og = xb_add(&bar[XB_TOP], 1u);
            const unsigned tg = og / nx;
            if (og + 1u == (tg + 1u) * nx) xb_add(&bar[XB_TOPGEN], 1u);
            else XB_SPIN(xb_ld(&bar[XB_TOPGEN]) == tg, bar);
            __builtin_amdgcn_fence(__ATOMIC_ACQUIRE, "agent");
            xb_add(&bar[XB_XGEN(b.x)], 1u);
            asm volatile("s_waitcnt vmcnt(0)" ::: "memory");
        } else {
            XB_SPIN(xb_ld(&bar[XB_XGEN(b.x)]) == gen, bar);
            __builtin_amdgcn_fence(__ATOMIC_ACQUIRE, "agent");
            asm volatile("s_waitcnt vmcnt(0)" ::: "memory");
        }
    }
    __syncthreads();
}

typedef unsigned v2u __attribute__((ext_vector_type(2)));
struct KArgs { const void* in[25]; float* out; unsigned char* ws; int ph_lo, ph_hi; };
struct Ctx {
    LAS unsigned char* lds;
    int tid, lane, wave, G, bid;
    const __attribute__((address_space(4))) KArgs* ka;
    float* out; unsigned char* ws; gu32* ctl;
};
__device__ __forceinline__ float wave_sum(float v) {
#pragma unroll
    for (int o = 1; o < 64; o <<= 1) v += __shfl_xor(v, o);
    return v;
}
__device__ __forceinline__ float bf_lo(unsigned u) { return __uint_as_float(u << 16); }
__device__ __forceinline__ float bf_hi(unsigned u) { return __uint_as_float(u & 0xffff0000u); }
__device__ __forceinline__ unsigned cvtpk(float lo, float hi) { return pg8::cvt_pk_bf16(lo, hi); }
__device__ __forceinline__ float silu(float v) { return pg8::silu_f(v); }
__device__ __forceinline__ f32x4 mfma16(bf16x8 a, bf16x8 b, f32x4 c) { return __builtin_amdgcn_mfma_f32_16x16x32_bf16(a, b, c, 0, 0, 0); }
__device__ __forceinline__ void unpack8(const v4u q, float (&f)[8]) { f[0] = bf_lo(q.x); f[1] = bf_hi(q.x); f[2] = bf_lo(q.y); f[3] = bf_hi(q.y); f[4] = bf_lo(q.z); f[5] = bf_hi(q.z); f[6] = bf_lo(q.w); f[7] = bf_hi(q.w); }
__device__ __forceinline__ v4u pack8(const float (&f)[8]) { v4u o; o.x = cvtpk(f[0], f[1]); o.y = cvtpk(f[2], f[3]); o.z = cvtpk(f[4], f[5]); o.w = cvtpk(f[6], f[7]); return o; }
__device__ __forceinline__ float softplus_f(float v) {
    if (v > 20.f) return v;
    const float e = __expf(v), u = 1.0f + e;
    return (u == 1.0f) ? e : __logf(u) * (e / (u - 1.0f));
}

__device__ __forceinline__ void transpose_item(const float* W, int ldw, int k0, int n0, bf16* WT, int K, int drow0, LAS float* scr, int lane) {
#pragma unroll 8
    for (int i = 0; i < 32; ++i) { const int kk = 2 * i + (lane >> 5); scr[kk * 33 + (lane & 31)] = W[(size_t)(k0 + kk) * ldw + n0 + (lane & 31)]; }
    LDS_WAIT(); asm volatile("" ::: "memory");
    const int c = lane & 7;
#pragma unroll
    for (int j = 0; j < 4; ++j) { const int n = (lane >> 3) + 8 * j; const LAS float* s = scr + (8 * c) * 33 + n;
        v4u o; o.x = cvtpk(s[0 * 33], s[1 * 33]); o.y = cvtpk(s[2 * 33], s[3 * 33]); o.z = cvtpk(s[4 * 33], s[5 * 33]); o.w = cvtpk(s[6 * 33], s[7 * 33]);
        *(GAS v4u*)(WT + (size_t)(drow0 + n) * K + k0 + 8 * c) = o; }
    LDS_WAIT(); asm volatile("" ::: "memory");
}
__device__ __forceinline__ void p0_prologue(const Ctx& F) {
    LAS float* scr = (LAS float*)(F.lds + F.wave * 16384);
    const int gw = F.bid * NWAVES + F.wave, NGW = F.G * NWAVES, lane = F.lane;
    for (int it = gw; it < 96 * 8; it += NGW) {
        const int cg = it % 96, ks = it / 96, col = cg * 64 + lane;
        float a0 = 0.f, a1 = 0.f;
        const float* wp = ((const float*)F.ka->in[5]) + (size_t)(ks * 128) * MODW + col;
#pragma unroll 8
        for (int kk = 0; kk < 128; ++kk) { const int k = ks * 128 + kk; const float w = wp[(size_t)kk * MODW]; a0 += silu(((const float*)F.ka->in[1])[k]) * w; a1 += silu(((const float*)F.ka->in[1])[DM + k]) * w; }
        ((float*)(F.ws + WS_MODP))[(size_t)(ks * 2 + 0) * MODW + col] = a0; ((float*)(F.ws + WS_MODP))[(size_t)(ks * 2 + 1) * MODW + col] = a1;
    }
    constexpr int I_IN = 16 * 72, I_OUT = 16 * 32, I_G = 32 * 16 * 8, I_D = 32 * 4 * 32, NITEMS = I_IN + I_OUT + 2 * I_G + I_D;
    for (int it = gw; it < NITEMS; it += NGW) {
        int r = it;
        if (r < I_IN) { const int kb = r / 72, nb = r % 72; transpose_item(((const float*)F.ka->in[7]), INW, 64 * kb, 32 * nb, ((bf16*)(F.ws + WS_WIN)), DM, 32 * nb, scr, lane); continue; } r -= I_IN;
        if (r < I_OUT) { const int kb = r / 32, nb = r % 32; transpose_item(((const float*)F.ka->in[17]), DM, 64 * kb, 32 * nb, ((bf16*)(F.ws + WS_WOUT)), DM, 32 * nb, scr, lane); continue; } r -= I_OUT;
        if (r < I_G) { const int e = r / 128, kb = (r % 128) / 8, nb = r % 8; transpose_item(((const float*)F.ka->in[22]) + (size_t)e * DM * DEXP, DEXP, 64 * kb, 32 * nb, ((bf16*)(F.ws + WS_WGU)), DM, e * 512 + (nb >> 2) * 256 + (nb & 3) * 32, scr, lane); continue; } r -= I_G;
        if (r < I_G) { const int e = r / 128, kb = (r % 128) / 8, nb = r % 8; transpose_item(((const float*)F.ka->in[23]) + (size_t)e * DM * DEXP, DEXP, 64 * kb, 32 * nb, ((bf16*)(F.ws + WS_WGU)), DM, e * 512 + (nb >> 2) * 256 + 128 + (nb & 3) * 32, scr, lane); continue; } r -= I_G;
        { const int e = r / 128, kb = (r % 128) / 32, nb = r % 32; transpose_item(((const float*)F.ka->in[24]) + (size_t)e * DEXP * DM, DM, 64 * kb, 32 * nb, ((bf16*)(F.ws + WS_WD)) + (size_t)e * DM * DEXP, DEXP, 32 * nb, scr, lane); }
    }
    const int gt = F.bid * 512 + F.tid, NGT = F.G * 512;
    for (int idx = gt; idx < 48 * DM; idx += NGT) { const int n = idx >> 10, k = idx & 1023;
        const float v = n < 4 ? ((const float*)F.ka->in[18])[k * 4 + n] : (n < 36 ? ((const float*)F.ka->in[20])[k * 32 + (n - 4)] : 0.f); ((bf16*)(F.ws + WS_WRT))[idx] = (bf16)f2bf(v); }
    for (int idx = gt; idx < M * 8; idx += NGT) { const int tok = idx >> 3, i = idx & 7;
        const double invf[8] = {1.0, 0.19392274474868576, 0.03760603093086393, 0.007292664737217109, 0.001414213562373095, 0.0002742481756762073, 5.318295896944988e-05, 1.031338537721246e-05};
        double fsel = invf[0];
#pragma unroll
        for (int q = 1; q < 8; ++q) fsel = (i == q) ? invf[q] : fsel;
        const double rev = (double)((const int*)F.ka->in[2])[tok] * fsel * 0.15915494309189535; const float fr = (float)(rev - __builtin_rint(rev));
        ((float*)(F.ws + WS_ROPE))[(size_t)tok * 16 + i] = __builtin_amdgcn_cosf(fr); ((float*)(F.ws + WS_ROPE))[(size_t)tok * 16 + 8 + i] = __builtin_amdgcn_sinf(fr); }
}

__device__ __forceinline__ float mod_at(const Ctx& F, int b, int j) { float s = ((const float*)F.ka->in[6])[j];
#pragma unroll
    for (int ks = 0; ks < 8; ++ks) s += ((float*)(F.ws + WS_MODP))[(size_t)(ks * 2 + b) * MODW + j];
    return s; }
__device__ __forceinline__ void p1_norm(const Ctx& F) {
    LAS float* g1s = (LAS float*)(F.lds); LAS float* sh1 = (LAS float*)(F.lds + 8192); LAS float* Wdt = (LAS float*)(F.lds + 16384);
    for (int idx = F.tid; idx < 2 * DM; idx += 512) { const int b = idx >> 10, k = idx & 1023; g1s[idx] = ((const float*)F.ka->in[3])[k] * (1.0f + mod_at(F, b, DM + k)); sh1[idx] = mod_at(F, b, k); }
    for (int idx = F.tid; idx < DM * 8; idx += 512) Wdt[idx] = ((const float*)F.ka->in[7])[(size_t)(idx >> 3) * INW + NPROJ + (idx & 7)];
    for (int idx = F.bid * 512 + F.tid; idx < 2 * MODW; idx += F.G * 512) { const int b = idx / MODW, j = idx % MODW; ((float*)(F.ws + WS_MOD))[idx] = mod_at(F, b, j); }
    __syncthreads();
    const int gw = F.bid * NWAVES + F.wave, NGW = F.G * NWAVES, lane = F.lane;
    for (int m = gw; m < M; m += NGW) {
        const int b = m >= SEQ ? 1 : 0;
        const GAS f32x4* xr = (const GAS f32x4*)(((const float*)F.ka->in[0]) + (size_t)m * DM) + lane;
        f32x4 v[4]; float s = 0.f;
#pragma unroll
        for (int j = 0; j < 4; ++j) { v[j] = xr[64 * j]; s += (v[j].x * v[j].x + v[j].y * v[j].y) + (v[j].z * v[j].z + v[j].w * v[j].w); }
        const float rstd = rsqrtf(wave_sum(s) * (1.f / DM) + EPS);
        float dacc[8];
#pragma unroll
        for (int q = 0; q < 8; ++q) dacc[q] = 0.f;
        GAS v2u* o8 = (GAS v2u*)(((bf16*)(F.ws + WS_XN)) + (size_t)m * DM) + lane;
#pragma unroll
        for (int j = 0; j < 4; ++j) { const int k0 = 4 * lane + 256 * j;
            const f32x4 gg = *(const LAS f32x4*)(g1s + b * DM + k0), ss = *(const LAS f32x4*)(sh1 + b * DM + k0);
            const f32x4 h = v[j] * rstd * gg + ss;
            v2u o; o.x = cvtpk(h.x, h.y); o.y = cvtpk(h.z, h.w); o8[64 * j] = o;
#pragma unroll
            for (int i = 0; i < 4; ++i) { const f32x4 w0 = *(const LAS f32x4*)(Wdt + (k0 + i) * 8), w1 = *(const LAS f32x4*)(Wdt + (k0 + i) * 8 + 4); const float hv = h[i];
                dacc[0] += hv * w0.x; dacc[1] += hv * w0.y; dacc[2] += hv * w0.z; dacc[3] += hv * w0.w; dacc[4] += hv * w1.x; dacc[5] += hv * w1.y; dacc[6] += hv * w1.z; dacc[7] += hv * w1.w; } }
#pragma unroll
        for (int q = 0; q < 8; ++q) dacc[q] = wave_sum(dacc[q]);
        if (lane == 0) { GAS f32x4* dp = (GAS f32x4*)(((float*)(F.ws + WS_DTRAW)) + (size_t)m * 8); dp[0] = (f32x4){dacc[0], dacc[1], dacc[2], dacc[3]}; dp[1] = (f32x4){dacc[4], dacc[5], dacc[6], dacc[7]}; }
    }
}

__device__ __forceinline__ void attn_unit(const Ctx& F, int b, int blk, int kvh) {
    constexpr int KSTR = 144, VSTR = 528;
    LAS unsigned char* Ks = F.lds; LAS unsigned char* Vt = F.lds + 36864;
    const int tid = F.tid, lane = F.lane, w = F.wave, fr = lane & 15, g = lane >> 4;
    __syncthreads();
    {
        const int kr = tid >> 1, half = tid & 1, tok = blk * 128 - 128 + kr;
        const size_t grow = (size_t)b * SEQ + (tok < 0 ? 0 : tok);
        const bf16* rowp = ((bf16*)(F.ws + WS_PROJ)) + grow * NPROJ;
        v4u kq[4], vq[4];
#pragma unroll
        for (int i = 0; i < 4; ++i) { kq[i] = *(const GAS v4u*)(rowp + C_K + kvh * 64 + half * 32 + 8 * i); vq[i] = *(const GAS v4u*)(rowp + C_V + kvh * 64 + half * 32 + 8 * i); }
        if (tok < 0) {
#pragma unroll
            for (int i = 0; i < 4; ++i) { kq[i] = (v4u){0u, 0u, 0u, 0u}; vq[i] = (v4u){0u, 0u, 0u, 0u}; } }
        float f[4][8]; float ssq = 0.f;
#pragma unroll
        for (int i = 0; i < 4; ++i) { unpack8(kq[i], f[i]);
#pragma unroll
            for (int j = 0; j < 8; ++j) ssq += f[i][j] * f[i][j]; }
        ssq += __shfl_xor(ssq, 1);
        const float rstd = rsqrtf(ssq * (1.f / 64.f) + EPS);
#pragma unroll
        for (int i = 0; i < 4; ++i) { const f32x4 w0 = *(const GAS f32x4*)(((const float*)F.ka->in[15]) + half * 32 + 8 * i), w1 = *(const GAS f32x4*)(((const float*)F.ka->in[15]) + half * 32 + 8 * i + 4);
            f[i][0] *= rstd * w0.x; f[i][1] *= rstd * w0.y; f[i][2] *= rstd * w0.z; f[i][3] *= rstd * w0.w; f[i][4] *= rstd * w1.x; f[i][5] *= rstd * w1.y; f[i][6] *= rstd * w1.z; f[i][7] *= rstd * w1.w; }
        {
            const GAS f32x4* rp = (const GAS f32x4*)(((float*)(F.ws + WS_ROPE)) + grow * 16);
            const f32x4 c0 = rp[0], c1 = rp[1], s0 = rp[2], s1 = rp[3];
            const float cs[8] = {c0.x, c0.y, c0.z, c0.w, c1.x, c1.y, c1.z, c1.w}, sn[8] = {s0.x, s0.y, s0.z, s0.w, s1.x, s1.y, s1.z, s1.w};
            if (half == 0) {
#pragma unroll
                for (int j = 0; j < 8; ++j) { const float x1 = f[0][j], x2 = f[1][j]; f[0][j] = x1 * cs[j] - x2 * sn[j]; f[1][j] = x2 * cs[j] + x1 * sn[j]; } }
        }
#pragma unroll
        for (int i = 0; i < 4; ++i) *(LAS v4u*)(Ks + kr * KSTR + half * 64 + i * 16) = pack8(f[i]);
#pragma unroll
        for (int i = 0; i < 4; ++i) { const unsigned wv[4] = {vq[i].x, vq[i].y, vq[i].z, vq[i].w};
#pragma unroll
            for (int q = 0; q < 4; ++q) { const int d = half * 32 + 8 * i + 2 * q;
                *(LAS unsigned short*)(Vt + d * VSTR + kr * 2) = (unsigned short)(wv[q] & 0xffffu); *(LAS unsigned short*)(Vt + (d + 1) * VSTR + kr * 2) = (unsigned short)(wv[q] >> 16); } }
    }
    __syncthreads();
    const int hq = kvh * 4 + (w >> 1), qb = 64 * (w & 1);
    const float sink = ((const float*)F.ka->in[16])[hq];
#pragma unroll 1
    for (int mt = 0; mt < 4; ++mt) {
        const int qi = qb + 16 * mt + fr; const size_t grow = (size_t)b * SEQ + blk * 128 + qi;
        const bf16* qp = ((bf16*)(F.ws + WS_PROJ)) + grow * NPROJ + C_Q + hq * 64 + 8 * g;
        const v4u q0 = *(const GAS v4u*)(qp), q1 = *(const GAS v4u*)(qp + 32);
        float f0[8], f1[8]; unpack8(q0, f0); unpack8(q1, f1);
        float ssq = 0.f;
#pragma unroll
        for (int j = 0; j < 8; ++j) ssq += f0[j] * f0[j] + f1[j] * f1[j];
        ssq += __shfl_xor(ssq, 16); ssq += __shfl_xor(ssq, 32);
        const float rstd = rsqrtf(ssq * (1.f / 64.f) + EPS);
        {   const f32x4 a0 = *(const GAS f32x4*)(((const float*)F.ka->in[14]) + 8 * g), a1 = *(const GAS f32x4*)(((const float*)F.ka->in[14]) + 8 * g + 4), b0 = *(const GAS f32x4*)(((const float*)F.ka->in[14]) + 32 + 8 * g), b1 = *(const GAS f32x4*)(((const float*)F.ka->in[14]) + 32 + 8 * g + 4);
            const float wa[8] = {a0.x, a0.y, a0.z, a0.w, a1.x, a1.y, a1.z, a1.w}, wb[8] = {b0.x, b0.y, b0.z, b0.w, b1.x, b1.y, b1.z, b1.w};
#pragma unroll
            for (int j = 0; j < 8; ++j) { f0[j] *= rstd * wa[j]; f1[j] *= rstd * wb[j]; } }
        {   const GAS f32x4* rp = (const GAS f32x4*)(((float*)(F.ws + WS_ROPE)) + grow * 16);
            const f32x4 c0 = rp[0], c1 = rp[1], s0 = rp[2], s1 = rp[3];
            const float cs[8] = {c0.x, c0.y, c0.z, c0.w, c1.x, c1.y, c1.z, c1.w}, sn[8] = {s0.x, s0.y, s0.z, s0.w, s1.x, s1.y, s1.z, s1.w};
#pragma unroll
            for (int j = 0; j < 8; ++j) { const float pr = __shfl_xor(f0[j], 16); const float r0 = f0[j] * cs[j] - pr * sn[j], r1 = f0[j] * cs[j] + pr * sn[j]; f0[j] = (g == 0) ? r0 : ((g == 1) ? r1 : f0[j]); } }
#pragma unroll
        for (int j = 0; j < 8; ++j) { f0[j] *= 0.125f; f1[j] *= 0.125f; }
        const bf16x8 qf0 = __builtin_bit_cast(bf16x8, pack8(f0)), qf1 = __builtin_bit_cast(bf16x8, pack8(f1));
        f32x4 acc[16];
#pragma unroll
        for (int kt = 0; kt < 16; ++kt) { acc[kt] = (f32x4){0.f, 0.f, 0.f, 0.f};
            const bf16x8 a0 = *(const LAS bf16x8*)(Ks + (16 * kt + fr) * KSTR + 16 * g), a1 = *(const LAS bf16x8*)(Ks + (16 * kt + fr) * KSTR + 64 + 16 * g);
            acc[kt] = mfma16(a0, qf0, acc[kt]); acc[kt] = mfma16(a1, qf1, acc[kt]); if ((kt & 3) == 3) __builtin_amdgcn_sched_barrier(0); }
        float mx = -INFINITY;
#pragma unroll
        for (int kt = 0; kt < 16; ++kt)
#pragma unroll
            for (int i = 0; i < 4; ++i) { const int s = 16 * kt + 4 * g + i, diff = qi + 128 - s; const bool valid = diff >= 0 && diff < 128 && (blk > 0 || s >= 128);
                const float v = valid ? acc[kt][i] : -INFINITY; acc[kt][i] = v; mx = fmaxf(mx, v); }
        mx = fmaxf(mx, __shfl_xor(mx, 16)); mx = fmaxf(mx, __shfl_xor(mx, 32)); mx = fmaxf(mx, sink);
        float sum = 0.f;
#pragma unroll
        for (int kt = 0; kt < 16; ++kt)
#pragma unroll
            for (int i = 0; i < 4; ++i) { const float p = __expf(acc[kt][i] - mx); acc[kt][i] = p; sum += p; }
        sum += __shfl_xor(sum, 16); sum += __shfl_xor(sum, 32); sum += __expf(sink - mx);
        const float inv = 1.0f / sum;
        f32x4 o[4];
#pragma unroll
        for (int dt = 0; dt < 4; ++dt) o[dt] = (f32x4){0.f, 0.f, 0.f, 0.f};
#pragma unroll
        for (int kk = 0; kk < 8; ++kk) {
            v4u pb; pb.x = cvtpk(acc[2 * kk][0], acc[2 * kk][1]); pb.y = cvtpk(acc[2 * kk][2], acc[2 * kk][3]); pb.z = cvtpk(acc[2 * kk + 1][0], acc[2 * kk + 1][1]); pb.w = cvtpk(acc[2 * kk + 1][2], acc[2 * kk + 1][3]);
            const bf16x8 bfrag = __builtin_bit_cast(bf16x8, pb);
#pragma unroll
            for (int dt = 0; dt < 4; ++dt) { const LAS unsigned char* vp = Vt + (16 * dt + fr) * VSTR + (32 * kk + 4 * g) * 2;
                const v2u lo = *(const LAS v2u*)vp, hi = *(const LAS v2u*)(vp + 32); const v4u av = {lo.x, lo.y, hi.x, hi.y};
                o[dt] = mfma16(__builtin_bit_cast(bf16x8, av), bfrag, o[dt]); }
            __builtin_amdgcn_sched_barrier(0); }
        bf16* op = ((bf16*)(F.ws + WS_MIX)) + grow * DM + hq * 64 + 4 * g;
#pragma unroll
        for (int dt = 0; dt < 4; ++dt) { v2u ov; ov.x = cvtpk(o[dt][0] * inv, o[dt][1] * inv); ov.y = cvtpk(o[dt][2] * inv, o[dt][3] * inv); *(GAS v2u*)(op + 16 * dt) = ov; }
    }
}

__device__ __forceinline__ void ssd_dt_cumsum(const Ctx& F, int b, int c, int grp, LAS float* dts, LAS float* acs, bool write_chdec) {
    const int w = F.wave, lane = F.lane;
    if (w < 4) { const int h = grp * 4 + w; const float A = -__expf(((const float*)F.ka->in[11])[h]), bias = ((const float*)F.ka->in[10])[h];
        const size_t row0 = (size_t)b * SEQ + c * 128;
        const float d0 = softplus_f(((float*)(F.ws + WS_DTRAW))[(row0 + lane) * 8 + h] + bias), d1 = softplus_f(((float*)(F.ws + WS_DTRAW))[(row0 + 64 + lane) * 8 + h] + bias);
        float s0 = d0 * A, s1 = d1 * A;
#pragma unroll
        for (int o = 1; o < 64; o <<= 1) { const float t0 = __shfl_up(s0, o), t1 = __shfl_up(s1, o); if (lane >= o) { s0 += t0; s1 += t1; } }
        s1 += __shfl(s0, 63);
        dts[w * 128 + lane] = d0; dts[w * 128 + 64 + lane] = d1; acs[w * 128 + lane] = s0; acs[w * 128 + 64 + lane] = s1;
        if (write_chdec && lane == 63) ((float*)(F.ws + WS_CHDEC))[((size_t)b * 64 + c) * 8 + h] = __expf(s1);
    }
}
__device__ __forceinline__ void conv_row8(const v4u x0, const v4u x1, const v4u x2, const v4u x3, const float (&w)[4][8], const float (&bias)[8], float (&y)[8]) {
    float a[8], bq[8], cq[8], d[8]; unpack8(x0, a); unpack8(x1, bq); unpack8(x2, cq); unpack8(x3, d);
#pragma unroll
    for (int j = 0; j < 8; ++j) { const float v = bias[j] + w[0][j] * a[j] + w[1][j] * bq[j] + w[2][j] * cq[j] + w[3][j] * d[j]; y[j] = silu(v); }
}
__device__ __forceinline__ void conv_load_w(const Ctx& F, int ch0, float (&w)[4][8], float (&bias)[8]) {
#pragma unroll
    for (int k = 0; k < 4; ++k) { const f32x4 a = *(const GAS f32x4*)(((const float*)F.ka->in[8]) + k * 1024 + ch0), bq = *(const GAS f32x4*)(((const float*)F.ka->in[8]) + k * 1024 + ch0 + 4);
        w[k][0] = a.x; w[k][1] = a.y; w[k][2] = a.z; w[k][3] = a.w; w[k][4] = bq.x; w[k][5] = bq.y; w[k][6] = bq.z; w[k][7] = bq.w; }
    const f32x4 a = *(const GAS f32x4*)(((const float*)F.ka->in[9]) + ch0), bq = *(const GAS f32x4*)(((const float*)F.ka->in[9]) + ch0 + 4);
    bias[0] = a.x; bias[1] = a.y; bias[2] = a.z; bias[3] = a.w; bias[4] = bq.x; bias[5] = bq.y; bias[6] = bq.z; bias[7] = bq.w;
}
__device__ __forceinline__ v4u xbc_load(const Ctx& F, int b, int t, int ch0) {
    if (t < 0) return (v4u){0u, 0u, 0u, 0u};
    return *(const GAS v4u*)(((bf16*)(F.ws + WS_PROJ)) + ((size_t)b * SEQ + t) * NPROJ + C_XBC + ch0);
}
template <bool TRANSPOSED_B, bool SCALE_X>
__device__ __forceinline__ void ssd_conv_stage(const Ctx& F, int b, int c, int grp, const LAS float* dts, const LAS float* acs, LAS unsigned char* Bdst, LAS unsigned char* XT) {
    const int tid = F.tid;
    if (tid < 480) {
        const int co = tid % 48, seg = tid / 48, l_lo = seg * 13, l_hi = (l_lo + 13 < 128) ? l_lo + 13 : 128;
        const bool isx = co < 32;
        const int ch0 = isx ? grp * 256 + co * 8 : 512 + grp * 128 + (co - 32) * 8;
        float w[4][8], bias[8]; conv_load_w(F, ch0, w, bias);
        const int t0 = c * 128 + l_lo;
        v4u x0 = xbc_load(F, b, t0 - 3, ch0), x1 = xbc_load(F, b, t0 - 2, ch0), x2 = xbc_load(F, b, t0 - 1, ch0);
        const int hh = co >> 3, p0 = (co & 7) * 8, n0 = (co - 32) * 8;
        for (int l = l_lo; l < l_hi; ++l) {
            const v4u x3 = xbc_load(F, b, c * 128 + l, ch0);
            float y[8]; conv_row8(x0, x1, x2, x3, w, bias, y);
            x0 = x1; x1 = x2; x2 = x3;
            if (isx) {
                float sc = 1.0f;
                if (SCALE_X) sc = dts[hh * 128 + l] * __expf(acs[hh * 128 + 127] - acs[hh * 128 + l]);
#pragma unroll
                for (int j = 0; j < 8; ++j) *(LAS unsigned short*)(XT + ((hh * 64 + p0 + j) * 136 + l) * 2) = (unsigned short)(cvtpk(y[j] * sc, 0.f) & 0xffffu);
            } else if (TRANSPOSED_B) {
#pragma unroll
                for (int j = 0; j < 8; ++j) *(LAS unsigned short*)(Bdst + ((n0 + j) * 136 + l) * 2) = (unsigned short)(cvtpk(y[j], 0.f) & 0xffffu);
            } else {
                *(LAS v4u*)(Bdst + (l * 136 + n0) * 2) = pack8(y);
            }
        }
    }
}

__device__ __forceinline__ void ssd_states_unit(const Ctx& F, int b, int c, int grp) {
    LAS float* dts = (LAS float*)(F.lds); LAS float* acs = (LAS float*)(F.lds + 2048);
    LAS unsigned char* BT = F.lds + 4096; LAS unsigned char* XT = F.lds + 4096 + 34816;
    const int lane = F.lane, w = F.wave, fr = lane & 15, g = lane >> 4;
    __syncthreads();
    ssd_dt_cumsum(F, b, c, grp, dts, acs, true);
    __syncthreads();
    ssd_conv_stage<true, true>(F, b, c, grp, dts, acs, BT, XT);
    __syncthreads();
    const int hh = w >> 1, nt0 = 4 * (w & 1), h = grp * 4 + hh;
    f32x4 acc[4][4];
#pragma unroll
    for (int a = 0; a < 4; ++a)
#pragma unroll
        for (int p = 0; p < 4; ++p) acc[a][p] = (f32x4){0.f, 0.f, 0.f, 0.f};
#pragma unroll
    for (int ks = 0; ks < 4; ++ks) {
        bf16x8 af[4], bfq[4];
#pragma unroll
        for (int a = 0; a < 4; ++a) af[a] = *(const LAS bf16x8*)(BT + ((16 * (nt0 + a) + fr) * 136 + 32 * ks + 8 * g) * 2);
#pragma unroll
        for (int p = 0; p < 4; ++p) bfq[p] = *(const LAS bf16x8*)(XT + ((hh * 64 + 16 * p + fr) * 136 + 32 * ks + 8 * g) * 2);
#pragma unroll
        for (int a = 0; a < 4; ++a)
#pragma unroll
            for (int p = 0; p < 4; ++p) acc[a][p] = mfma16(af[a], bfq[p], acc[a][p]);
    }
    float* sp = ((float*)(F.ws + WS_STATES)) + (((size_t)b * 64 + c) * 8 + h) * 64 * 128;
#pragma unroll
    for (int a = 0; a < 4; ++a)
#pragma unroll
        for (int p = 0; p < 4; ++p) *(GAS f32x4*)(sp + (size_t)(16 * p + fr) * 128 + 16 * (nt0 + a) + 4 * g) = acc[a][p];
}

__device__ __forceinline__ void ssd_scan(const Ctx& F) {
    for (int e = F.bid * 512 + F.tid; e < BATCH * 65536; e += F.G * 512) {
        const int b = e >> 16, rem = e & 65535, h = rem >> 13;
        float carry = 0.f;
        const float* sp = ((float*)(F.ws + WS_STATES)) + (size_t)b * 64 * 65536 + rem; bf16* pp = ((bf16*)(F.ws + WS_PREV)) + (size_t)b * 64 * 65536 + rem; const float* dp = ((float*)(F.ws + WS_CHDEC)) + (size_t)b * 64 * 8 + h;
#pragma unroll 8
        for (int c = 0; c < 64; ++c) { const float st = sp[(size_t)c * 65536], dec = dp[c * 8]; pp[(size_t)c * 65536] = (bf16)f2bf(carry); carry = carry * dec + st; }
    }
}

__device__ __forceinline__ void ssd_out_unit(const Ctx& F, int b, int c, int grp) {
    LAS float* dts = (LAS float*)(F.lds); LAS float* acs = (LAS float*)(F.lds + 2048);
    LAS unsigned char* Bs = F.lds + 4096; LAS unsigned char* XT = F.lds + 4096 + 34816;
    int lane = F.lane; asm volatile("" : "+v"(lane));
    const int w = F.wave, fr = lane & 15, g = lane >> 4;
    __syncthreads();
    ssd_dt_cumsum(F, b, c, grp, dts, acs, false);
    __syncthreads();
    ssd_conv_stage<false, false>(F, b, c, grp, dts, acs, Bs, XT);
    const int l = 16 * w + fr, t = c * 128 + l; const size_t grow = (size_t)b * SEQ + t;
    bf16x8 cf[4];
#pragma unroll
    for (int ks = 0; ks < 4; ++ks) { const int ch0 = 768 + grp * 128 + 32 * ks + 8 * g;
        float cw_[4][8], cb_[8]; conv_load_w(F, ch0, cw_, cb_);
        float y[8]; conv_row8(xbc_load(F, b, t - 3, ch0), xbc_load(F, b, t - 2, ch0), xbc_load(F, b, t - 1, ch0), xbc_load(F, b, t, ch0), cw_, cb_, y);
        cf[ks] = __builtin_bit_cast(bf16x8, pack8(y)); asm volatile("" : "+v"(cf[ks]) :: "memory"); __builtin_amdgcn_sched_barrier(0); }
    __syncthreads();
    f32x4 cb[8];
#pragma unroll
    for (int st = 0; st < 8; ++st) { cb[st] = (f32x4){0.f, 0.f, 0.f, 0.f};
        if (st <= w) {
#pragma unroll
            for (int ks = 0; ks < 4; ++ks) cb[st] = mfma16(*(const LAS bf16x8*)(Bs + ((16 * st + fr) * 136 + 32 * ks + 8 * g) * 2), cf[ks], cb[st]); } }
    f32x4 yv[4][4]; float ysum = 0.f;
#pragma unroll
    for (int hh = 0; hh < 4; ++hh) { const int h = grp * 4 + hh;
        const float acl = acs[hh * 128 + l];
        f32x4 y[4];
#pragma unroll
        for (int pt = 0; pt < 4; ++pt) y[pt] = (f32x4){0.f, 0.f, 0.f, 0.f};
        const bf16* pp = ((bf16*)(F.ws + WS_PREV)) + (((size_t)b * 64 + c) * 8 + h) * 64 * 128;
#pragma unroll
        for (int ks = 0; ks < 4; ++ks)
#pragma unroll
            for (int pt = 0; pt < 4; ++pt) y[pt] = mfma16(*(const GAS bf16x8*)(pp + (size_t)(16 * pt + fr) * 128 + 32 * ks + 8 * g), cf[ks], y[pt]);
        __builtin_amdgcn_sched_barrier(0);
        const float eal = __expf(acl);
#pragma unroll
        for (int pt = 0; pt < 4; ++pt) y[pt] = y[pt] * eal;
#pragma unroll
        for (int kk = 0; kk < 4; ++kk) if (2 * kk <= w) {
            float mv[8];
#pragma unroll
            for (int q = 0; q < 2; ++q) { const int st = 2 * kk + q;
                const f32x4 as4 = *(const LAS f32x4*)(acs + hh * 128 + 16 * st + 4 * g), ds4 = *(const LAS f32x4*)(dts + hh * 128 + 16 * st + 4 * g);
#pragma unroll
                for (int i = 0; i < 4; ++i) { const bool ok = (st < w) || (st == w && (4 * g + i) <= fr); mv[4 * q + i] = ok ? cb[st][i] * __expf(acl - as4[i]) * ds4[i] : 0.f; } }
            const bf16x8 bfrag = __builtin_bit_cast(bf16x8, pack8(mv));
#pragma unroll
            for (int pt = 0; pt < 4; ++pt) { const LAS unsigned char* xp = XT + ((hh * 64 + 16 * pt + fr) * 136 + 32 * kk + 4 * g) * 2;
                const v2u lo = *(const LAS v2u*)xp, hi = *(const LAS v2u*)(xp + 32); const v4u av = {lo.x, lo.y, hi.x, hi.y};
                y[pt] = mfma16(__builtin_bit_cast(bf16x8, av), bfrag, y[pt]); } }
        const float dsk = ((const float*)F.ka->in[12])[h];
#pragma unroll
        for (int pt = 0; pt < 4; ++pt) { const v2u zq = *(const GAS v2u*)(((bf16*)(F.ws + WS_PROJ)) + grow * NPROJ + C_Z + h * 64 + 16 * pt + 4 * g);
            const float z[4] = {bf_lo(zq.x), bf_hi(zq.x), bf_lo(zq.y), bf_hi(zq.y)};
#pragma unroll
            for (int i = 0; i < 4; ++i) { const int p = 16 * pt + 4 * g + i; const float xs = __uint_as_float((unsigned)(*(const LAS unsigned short*)(XT + ((hh * 64 + p) * 136 + l) * 2)) << 16);
                const float v = (y[pt][i] + dsk * xs) * silu(z[i]); yv[hh][pt][i] = v; ysum += v * v; } }
        __builtin_amdgcn_sched_barrier(0);
    }
    ysum += __shfl_xor(ysum, 16); ysum += __shfl_xor(ysum, 32);
    const float rstd = rsqrtf(ysum * (1.f / 256.f) + EPS);
#pragma unroll
    for (int hh = 0; hh < 4; ++hh)
#pragma unroll
        for (int pt = 0; pt < 4; ++pt) { const int ch = (grp * 4 + hh) * 64 + 16 * pt + 4 * g; const f32x4 nw = *(const GAS f32x4*)(((const float*)F.ka->in[13]) + ch);
            v2u ov; ov.x = cvtpk(yv[hh][pt][0] * rstd * nw.x, yv[hh][pt][1] * rstd * nw.y); ov.y = cvtpk(yv[hh][pt][2] * rstd * nw.z, yv[hh][pt][3] * rstd * nw.w);
            *(GAS v2u*)(((bf16*)(F.ws + WS_MIX)) + grow * DM + 512 + ch) = ov; }
}

__device__ __forceinline__ void p7_router(const Ctx& F) {
    LAS float* g2s = (LAS float*)(F.lds); LAS float* sh2 = (LAS float*)(F.lds + 8192); LAS float* lgw = (LAS float*)(F.lds + 16384) + F.wave * (16 * 48);
    for (int idx = F.tid; idx < 2 * DM; idx += 512) { const int b = idx >> 10, k = idx & 1023; g2s[idx] = ((const float*)F.ka->in[4])[k] * (1.0f + ((float*)(F.ws + WS_MOD))[b * MODW + 4 * DM + k]); sh2[idx] = ((float*)(F.ws + WS_MOD))[b * MODW + 3 * DM + k]; }
    __syncthreads();
    const int gw = F.bid * NWAVES + F.wave, NGW = F.G * NWAVES, lane = F.lane, fr = lane & 15, g = lane >> 4;
    for (int rt = gw; rt < M / 16; rt += NGW) {
        const int row = rt * 16 + fr, b = (rt * 16) >= SEQ ? 1 : 0;
        const float* xr = F.out + (size_t)row * DM + 8 * g;
        float ssq = 0.f;
#pragma unroll 8
        for (int ks = 0; ks < 32; ++ks) { const f32x4 a = *(const GAS f32x4*)(xr + 32 * ks), c4 = *(const GAS f32x4*)(xr + 32 * ks + 4); ssq += (a.x * a.x + a.y * a.y) + (a.z * a.z + a.w * a.w) + (c4.x * c4.x + c4.y * c4.y) + (c4.z * c4.z + c4.w * c4.w); }
        ssq += __shfl_xor(ssq, 16); ssq += __shfl_xor(ssq, 32);
        const float rstd = rsqrtf(ssq * (1.f / DM) + EPS);
        f32x4 acc[3];
#pragma unroll
        for (int nt = 0; nt < 3; ++nt) acc[nt] = (f32x4){0.f, 0.f, 0.f, 0.f};
        bf16* hp = ((bf16*)(F.ws + WS_XN)) + (size_t)row * DM + 8 * g;
#pragma unroll 4
        for (int ks = 0; ks < 32; ++ks) { const int k0 = 32 * ks + 8 * g;
            const f32x4 a = *(const GAS f32x4*)(xr + 32 * ks), c4 = *(const GAS f32x4*)(xr + 32 * ks + 4);
            const f32x4 ga = *(const LAS f32x4*)(g2s + b * DM + k0), gb = *(const LAS f32x4*)(g2s + b * DM + k0 + 4), sa = *(const LAS f32x4*)(sh2 + b * DM + k0), sb = *(const LAS f32x4*)(sh2 + b * DM + k0 + 4);
            const f32x4 ha = a * rstd * ga + sa, hb = c4 * rstd * gb + sb;
            v4u hq; hq.x = cvtpk(ha.x, ha.y); hq.y = cvtpk(ha.z, ha.w); hq.z = cvtpk(hb.x, hb.y); hq.w = cvtpk(hb.z, hb.w);
            *(GAS v4u*)(hp + 32 * ks) = hq;
            const bf16x8 hf = __builtin_bit_cast(bf16x8, hq);
#pragma unroll
            for (int nt = 0; nt < 3; ++nt) acc[nt] = mfma16(hf, *(const GAS bf16x8*)(((bf16*)(F.ws + WS_WRT)) + (size_t)(16 * nt + fr) * DM + k0), acc[nt]); }
#pragma unroll
        for (int nt = 0; nt < 3; ++nt)
#pragma unroll
            for (int i = 0; i < 4; ++i) lgw[(4 * g + i) * 48 + 16 * nt + fr] = acc[nt][i];
        LDS_WAIT(); asm volatile("" ::: "memory");
        if (lane < 16) {
            const LAS float* lr = lgw + lane * 48; const int token = rt * 16 + lane;
            float gl[4]; int gi = 0;
#pragma unroll
            for (int j = 0; j < 4; ++j) gl[j] = lr[j] + ((const float*)F.ka->in[19])[j];
            float gm = gl[0];
#pragma unroll
            for (int j = 1; j < 4; ++j) if (gl[j] > gm) { gm = gl[j]; gi = j; }
            float gs = 0.f;
#pragma unroll
            for (int j = 0; j < 4; ++j) gs += __expf(gl[j] - gm);
            const float gp = 1.0f / gs;
            float l1 = -INFINITY, l2 = -INFINITY; int i1 = 0, i2 = 0;
            for (int j = 0; j < 8; ++j) { const float v = lr[4 + gi * 8 + j] + ((const float*)F.ka->in[21])[gi * 8 + j];
                if (v > l1) { l2 = l1; i2 = i1; l1 = v; i1 = j; } else if (v > l2) { l2 = v; i2 = j; } }
            const float e21 = __expf(l2 - l1), w1 = 1.0f / (1.0f + e21), w2 = e21 * w1;
            ((float*)(F.ws + WS_CW))[token * 2 + 0] = gp * w1; ((float*)(F.ws + WS_CW))[token * 2 + 1] = gp * w2;
            const int e1 = gi * 8 + i1, e2 = gi * 8 + i2;
            const unsigned p1 = __hip_atomic_fetch_add((unsigned*)(F.ctl + CW_CNT) + e1, 1u, __ATOMIC_RELAXED, __HIP_MEMORY_SCOPE_AGENT);
            const unsigned p2 = __hip_atomic_fetch_add((unsigned*)(F.ctl + CW_CNT) + 32 + e2, 1u, __ATOMIC_RELAXED, __HIP_MEMORY_SCOPE_AGENT);
            ((int*)(F.ws + WS_TOK))[(size_t)e1 * TOKCAP + p1] = token; ((int*)(F.ws + WS_TOK))[(size_t)(32 + e2) * TOKCAP + p2] = token;
        }
        LDS_WAIT(); asm volatile("" ::: "memory");
    }
}

__device__ __forceinline__ void moe_tiles(const Ctx& F, LAS int* tb, LAS int* cn) {
    __syncthreads();
    if (F.tid < 64) cn[F.tid] = (int)__hip_atomic_load((unsigned*)(F.ctl + CW_CNT) + F.tid, __ATOMIC_RELAXED, __HIP_MEMORY_SCOPE_AGENT);
    __syncthreads();
    if (F.tid == 0) { int s = 0; for (int i = 0; i < 64; ++i) { tb[i] = s; s += (cn[i] + 255) >> 8; } tb[64] = s; }
    __syncthreads();
}
__device__ __forceinline__ int moe_find(const LAS int* tb, int T) { int idx = 0;
#pragma unroll 1
    for (int i = 1; i < 64; ++i) idx = (tb[i] <= T) ? i : idx;
    return idx; }
__device__ __forceinline__ void moe_up(const Ctx& F) {
    LAS int* tb = (LAS int*)(F.lds + MISC_OFF + 128); LAS int* cn = tb + 80;
    moe_tiles(F, tb, cn);
    const int NT = tb[64];
    for (int u = F.bid; u < 2 * NT; u += F.G) {
        const int T = u >> 1, nt = u & 1, idx = moe_find(tb, T), lt = T - tb[idx], e = idx & 31;
        int nvalid = cn[idx] - lt * 256; nvalid = nvalid > 256 ? 256 : nvalid;
        pg8::Gemm gm{((bf16*)(F.ws + WS_XN)), ((bf16*)(F.ws + WS_WGU)), 256, 256, DM, ((int*)(F.ws + WS_TOK)) + (size_t)idx * TOKCAP + lt * 256, nvalid};
        pg8::SingleUnit S{0, e * 2 + nt};
        pg8::EpiAct E{((bf16*)(F.ws + WS_ACT)) + (size_t)T * 256 * 256 + nt * 128};
        pg8::gemm_phase<pg8::EpiAct, pg8::SingleUnit, false, true, true>(F.lds, gm, S, E);
    }
}
__device__ __forceinline__ void moe_down(const Ctx& F, int slot) {
    LAS int* tb = (LAS int*)(F.lds + MISC_OFF + 128); LAS int* cn = tb + 80;
    moe_tiles(F, tb, cn);
    const int Tlo = tb[32 * slot], Thi = tb[32 * slot + 32];
    for (int u = F.bid; u < 4 * (Thi - Tlo); u += F.G) {
        const int T = Tlo + (u >> 2), pn = u & 3, idx = moe_find(tb, T), lt = T - tb[idx], e = idx & 31;
        int nvalid = cn[idx] - lt * 256; nvalid = nvalid > 256 ? 256 : nvalid;
        pg8::Gemm gm{((bf16*)(F.ws + WS_ACT)), ((bf16*)(F.ws + WS_WD)), 256, 256, DEXP, nullptr, 0};
        pg8::SingleUnit S{T, e * 4 + pn};
        pg8::EpiDown E{((int*)(F.ws + WS_TOK)) + (size_t)idx * TOKCAP + lt * 256, nvalid, ((float*)(F.ws + WS_CW)), slot, ((float*)(F.ws + WS_MOD)) + 5 * DM, MODW, SEQ, F.out};
        pg8::gemm_phase<pg8::EpiDown, pg8::SingleUnit, false, true, false>(F.lds, gm, S, E);
    }
}

constexpr int NPHASE = 11;
typedef KArgs Args;
__global__ void __launch_bounds__(NWAVES * 64, 2) hymba_fwd(Args args) {
    extern __shared__ __attribute__((aligned(16))) unsigned char lds_raw[];
    Ctx F;
    F.lds = (LAS unsigned char*)lds_raw;
    F.tid = threadIdx.x; F.lane = F.tid & 63; F.wave = __builtin_amdgcn_readfirstlane(F.tid >> 6); F.G = gridDim.x; F.bid = blockIdx.x;
    F.ka = (const __attribute__((address_space(4))) KArgs*)__builtin_amdgcn_kernarg_segment_ptr();
    F.out = args.out; F.ws = args.ws; F.ctl = (gu32*)(args.ws + WS_CTL);
    for (int u = F.tid; u < (LDS_BYTES - LDSCTL_OFF) / 4; u += NWAVES * 64) ((LAS unsigned*)(F.lds + LDSCTL_OFF))[u] = 0u;
    __syncthreads();
    const int lo = args.ph_lo, hi = args.ph_hi;
    const bool use_bar = (hi - lo) > 1;
    XcdBarrier bar; bar.bar = (unsigned*)(F.ctl + CW_BAR); bar.x = 0; bar.st = nullptr;
    if (use_bar) bar = xcd_barrier_post((unsigned*)(F.ctl + CW_BAR), (volatile LAS unsigned*)(F.lds + MISC_OFF) + 8);
#ifndef PH_MASK
#define PH_MASK 0x7ff
#endif
#define IN(k) (((PH_MASK >> (k)) & 1) && lo <= (k) && (k) < hi)
#define SEAM(k) do { if (IN(k) && IN((k) + 1)) xcd_barrier(bar); asm volatile("" : "+v"(F.tid), "+v"(F.lane), "+s"(F.ka)); } while (0)
    if (IN(0)) p0_prologue(F);
    SEAM(0);
    if (IN(1)) p1_norm(F);
    SEAM(1);
    if (IN(2)) { pg8::Gemm gm{((bf16*)(F.ws + WS_XN)), ((bf16*)(F.ws + WS_WIN)), M, NPROJ, DM, nullptr, 0}; pg8::StaticOrder S; S.init(M, NPROJ, F.G, F.bid); pg8::EpiBf16 E{((bf16*)(F.ws + WS_PROJ)), NPROJ};
        pg8::gemm_phase<pg8::EpiBf16, pg8::StaticOrder, true, true, false>(F.lds, gm, S, E); }
    SEAM(2);
    if (IN(3)) {
#ifndef TEST_NO_ATTN
        for (int u = F.bid; u < 256; u += F.G) attn_unit(F, u >> 7, (u >> 1) & 63, u & 1);
#endif
#ifndef TEST_NO_STATES
        for (int u = F.bid; u < 256; u += F.G) ssd_states_unit(F, u >> 7, (u >> 1) & 63, u & 1);
#endif
    }
    SEAM(3);
    if (IN(4)) ssd_scan(F);
    SEAM(4);
    if (IN(5)) { for (int u = F.bid; u < 256; u += F.G) ssd_out_unit(F, u >> 7, (u >> 1) & 63, u & 1); }
    SEAM(5);
    if (IN(6)) { __syncthreads(); pg8::Gemm gm{((bf16*)(F.ws + WS_MIX)), ((bf16*)(F.ws + WS_WOUT)), M, DM, DM, nullptr, 0}; pg8::StaticOrder S; S.init(M, DM, F.G, F.bid); pg8::EpiResGate E{((const float*)F.ka->in[0]), F.out, ((float*)(F.ws + WS_MOD)) + 2 * DM, MODW, SEQ};
        pg8::gemm_phase<pg8::EpiResGate, pg8::StaticOrder, true, true, false>(F.lds, gm, S, E); }
    SEAM(6);
    if (IN(7)) p7_router(F);
    SEAM(7);
    if (IN(8)) moe_up(F);
    SEAM(8);
    if (IN(9)) moe_down(F, 0);
    SEAM(9);
    if (IN(10)) moe_down(F, 1);
#undef IN
#undef SEAM
}

#ifndef N_LAUNCHES
#define N_LAUNCHES 1
#endif
extern "C" void kernel_launch(void* const* d_in, const int* in_sizes, int n_in, void* d_out, int out_size, void* d_ws, size_t ws_size, hipStream_t stream) {
    static int grid = 0;
    if (grid == 0) {
        if (n_in != 25 || in_sizes[0] != M * DM || out_size != M * DM || ws_size < WS_END) { fprintf(stderr, "kernel_launch: unexpected shapes (n_in %d, in0 %d, out %d, ws %zu)\n", n_in, n_in > 0 ? in_sizes[0] : -1, out_size, ws_size); grid = -1; return; }
        int dev = 0, cus = 0;
        if (hipGetDevice(&dev) != hipSuccess || hipDeviceGetAttribute(&cus, hipDeviceAttributeMultiprocessorCount, dev) != hipSuccess) { grid = -1; return; }
        if (hipFuncSetAttribute((const void*)hymba_fwd, hipFuncAttributeMaxDynamicSharedMemorySize, LDS_BYTES) != hipSuccess) { fprintf(stderr, "kernel_launch: hipFuncSetAttribute failed\n"); grid = -1; return; }
        int per_cu = 0;
        if (hipOccupancyMaxActiveBlocksPerMultiprocessor(&per_cu, (const void*)hymba_fwd, NWAVES * 64, LDS_BYTES) != hipSuccess || per_cu < 1) fprintf(stderr, "kernel_launch: occupancy query reports %d\n", per_cu);
        (void)hipGetLastError();
        grid = cus;
    }
    if (grid < 0) return;
    if (hipMemsetAsync((char*)d_ws + WS_CTL, 0, CTL_ZERO_BYTES, stream) != hipSuccess) return;
    Args a{};
    for (int i = 0; i < 25; ++i) a.in[i] = d_in[i];
    a.out = (float*)d_out; a.ws = (unsigned char*)d_ws;
    if (N_LAUNCHES == 1) { a.ph_lo = 0; a.ph_hi = NPHASE; hipLaunchKernelGGL(hymba_fwd, dim3(grid), dim3(NWAVES * 64), LDS_BYTES, stream, a); }
    else { for (int p = 0; p < NPHASE; ++p) { a.ph_lo = p; a.ph_hi = p + 1; hipLaunchKernelGGL(hymba_fwd, dim3(grid), dim3(NWAVES * 64), LDS_BYTES, stream, a); } }
}
```

```cpp
#include <hip/hip_runtime.h>
#include <cstdio>
#include <cstdint>
#include <cmath>
namespace pg8 {
#define PG8_LAS __attribute__((address_space(3)))
typedef unsigned short bf16_t;
typedef short bf16x8 __attribute__((ext_vector_type(8)));
typedef float f32x4 __attribute__((ext_vector_type(4)));
typedef unsigned u32x4 __attribute__((ext_vector_type(4)));
constexpr int BM = 256, BK = 64, HALF = 128, HTB = HALF * BK * 2  , STAGE_BYTES = 8 * HTB, NXCD = 8, WGM = 8;

__host__ __device__ __forceinline__ int lds_byte(int r, int c) { const int st = (r >> 4) * 2 + (c >> 5), rr = r & 15, cc = c & 31, ob = rr * 64 + cc * 2; return st * 1024 + (ob ^ (((ob >> 9) & 1) << 5)); }
__host__ __device__ __forceinline__ void stage_rc(int b, int& R, int& C) { const int st = b / 1024, sb = b % 1024, swz = sb ^ (((sb >> 9) & 1) << 5); R = (st >> 1) * 16 + swz / 64; C = (st & 1) * 32 + (swz % 64) / 2; }
__host__ __device__ __forceinline__ int perm32(int rho) { const int n = rho >> 4, i = rho & 15; return 8 * (i >> 2) + 4 * n + (i & 3); }

struct Unit { int pm, pn, pb; };
struct Gemm { const bf16_t* A; const bf16_t* Bt; int M, N, K; const int* gather; int nvalid; };

struct StaticOrder {
    int nM, nN, nwg, G, c;
    __host__ __device__ void init(int M, int N, int G_, int c_) { nM = M / BM; nN = N / BM; nwg = nM * nN; G = G_; c = c_; }
    __host__ __device__ bool next(int i, Unit& u) const {
        const long L = (long)i * G + c; if (L >= nwg) return false;
        int wgid = (int)L; { const int q = nwg / NXCD, r = nwg % NXCD, xcd = wgid % NXCD, off = wgid / NXCD; wgid = (xcd < r ? xcd * (q + 1) : r * (q + 1) + (xcd - r) * q) + off; }
        const int nig = WGM * nN, gid = wgid / nig, fm = gid * WGM, gsz = (nM - fm) < WGM ? (nM - fm) : WGM;
        u.pm = fm + ((wgid % nig) % gsz); u.pn = (wgid % nig) / gsz; u.pb = u.pn; return true;
    }
    __device__ __forceinline__ void a_ready(const Unit&) const {}
    __device__ __forceinline__ void done(const Unit&) const {}
};


__device__ __forceinline__ unsigned cvt_pk_bf16(float lo, float hi) { typedef float f2_t __attribute__((ext_vector_type(2))); typedef __bf16 b2_t __attribute__((ext_vector_type(2))); f2_t v = {lo, hi}; b2_t b = __builtin_convertvector(v, b2_t); return __builtin_bit_cast(unsigned, b); }
__device__ __forceinline__ float silu_f(float v) { return v * __builtin_amdgcn_rcpf(1.0f + __builtin_amdgcn_exp2f(-1.4426950408889634f * v)); }

struct SingleUnit {
    int pm, pn, pb;
    __device__ __forceinline__ bool next(int i, Unit& u) const { if (i != 0) return false; u.pm = pm; u.pn = pn; u.pb = pb; return true; }
    __device__ __forceinline__ void a_ready(const Unit&) const {}
    __device__ __forceinline__ void done(const Unit&) const {}
};

struct EpiBf16 {
    static constexpr bool PERM = true, AFTER_DRAIN = false;
    bf16_t* O; int ldc;
    __device__ __forceinline__ void operator()(const f32x4 (&acc)[2][2][4][2], const Unit& u, int wr, int wc, int fr, int fq) const {
        const int row0 = u.pm * BM + wr * 64 + fr, col0 = u.pn * BM + wc * 32 + 8 * fq;
#pragma unroll
        for (int ai = 0; ai < 2; ++ai)
#pragma unroll
            for (int m = 0; m < 4; ++m) { bf16_t* rowp = O + (size_t)(row0 + ai * HALF + m * 16) * ldc + col0;
#pragma unroll
                for (int bj = 0; bj < 2; ++bj) { const f32x4 v0 = acc[ai][bj][m][0], v1 = acc[ai][bj][m][1];
                    u32x4 w; w.x = cvt_pk_bf16(v0[0], v0[1]); w.y = cvt_pk_bf16(v0[2], v0[3]); w.z = cvt_pk_bf16(v1[0], v1[1]); w.w = cvt_pk_bf16(v1[2], v1[3]);
                    *(u32x4*)(rowp + bj * HALF) = w; } }
    }
};
struct EpiGateBf16 {
    static constexpr bool PERM = true, AFTER_DRAIN = false;
    bf16_t* O; int ldc; const float* gate; int gpitch; int rows_per_batch;
    __device__ __forceinline__ void operator()(const f32x4 (&acc)[2][2][4][2], const Unit& u, int wr, int wc, int fr, int fq) const {
        const int b = (u.pm * BM) / rows_per_batch; const float* gp = gate + (size_t)b * gpitch;
        const int row0 = u.pm * BM + wr * 64 + fr, col0 = u.pn * BM + wc * 32 + 8 * fq;
        f32x4 gv[2][2];
#pragma unroll
        for (int bj = 0; bj < 2; ++bj)
#pragma unroll
            for (int n = 0; n < 2; ++n) gv[bj][n] = *(const f32x4*)(gp + col0 + bj * HALF + 4 * n);
#pragma unroll
        for (int ai = 0; ai < 2; ++ai)
#pragma unroll
            for (int m = 0; m < 4; ++m) { bf16_t* rowp = O + (size_t)(row0 + ai * HALF + m * 16) * ldc + col0;
#pragma unroll
                for (int bj = 0; bj < 2; ++bj) { const f32x4 v0 = acc[ai][bj][m][0] * gv[bj][0], v1 = acc[ai][bj][m][1] * gv[bj][1];
                    u32x4 w; w.x = cvt_pk_bf16(v0[0], v0[1]); w.y = cvt_pk_bf16(v0[2], v0[3]); w.z = cvt_pk_bf16(v1[0], v1[1]); w.w = cvt_pk_bf16(v1[2], v1[3]);
                    *(u32x4*)(rowp + bj * HALF) = w; } }
    }
};
struct EpiAct {
    static constexpr bool PERM = true, AFTER_DRAIN = false;
    bf16_t* O;
    __device__ __forceinline__ void operator()(const f32x4 (&acc)[2][2][4][2], const Unit& u, int wr, int wc, int fr, int fq) const {
        const int col0 = wc * 32 + 8 * fq;
#pragma unroll
        for (int ai = 0; ai < 2; ++ai)
#pragma unroll
            for (int m = 0; m < 4; ++m) { const int rl = ai * HALF + wr * 64 + m * 16 + fr;
                float a[8];
#pragma unroll
                for (int n = 0; n < 2; ++n)
#pragma unroll
                    for (int i = 0; i < 4; ++i) a[4 * n + i] = silu_f(acc[ai][0][m][n][i]) * acc[ai][1][m][n][i];
                u32x4 w; w.x = cvt_pk_bf16(a[0], a[1]); w.y = cvt_pk_bf16(a[2], a[3]); w.z = cvt_pk_bf16(a[4], a[5]); w.w = cvt_pk_bf16(a[6], a[7]);
                *(u32x4*)(O + (size_t)rl * 256 + col0) = w; asm volatile("" ::: "memory"); }
    }
};

template <class Epi, class Sched, bool ALIGN_EPI = false, bool SP2 = false, bool GATHER = false>
__device__ __forceinline__ void gemm_phase(PG8_LAS unsigned char* lds, const Gemm g, const Sched& S, const Epi& E) {
    const int tid = threadIdx.x, wid = __builtin_amdgcn_readfirstlane(tid >> 6), lane = tid & 63, wr = wid >> 2, wc = wid & 3, fr = lane & 15, fq = lane >> 4;
    const int K = g.K, nt = K / BK;
    unsigned voffA[2], voffA1[2], voffB[2];
#pragma unroll
    for (int i = 0; i < 2; ++i) { int R, C; stage_rc(tid * 16 + i * 8192, R, C); const int Rb = Epi::PERM ? ((R & ~31) + perm32(R & 31)) : R;
        voffB[i] = (unsigned)(Rb * K + C) * 2u;
        if constexpr (GATHER) { const int t0 = (R < g.nvalid) ? g.gather[R] : g.gather[0]; const int t1 = (R + HALF < g.nvalid) ? g.gather[R + HALF] : g.gather[0];
            voffA[i] = (unsigned)(t0 * K + C) * 2u; voffA1[i] = (unsigned)(t1 * K + C) * 2u; }
        else { voffA[i] = (unsigned)(R * K + C) * 2u; voffA1[i] = voffA[i]; } }
    const size_t kstep = (size_t)(BK * 2);
    const size_t hstep = (size_t)HALF * K * 2;
    const size_t tstep = 2 * hstep;
    const size_t hstepA = GATHER ? (size_t)0 : hstep;
    const unsigned ldsw = (unsigned)wid * 1024u;
    const int aoff = lds_byte(wr * 64 + fr, fq * 8), boff = lds_byte(wc * 32 + fr, fq * 8);
#define PG8_SA(b, h) (((b) * 2 + (h)) * HTB)
#define PG8_SB(b, h) ((4 + (b) * 2 + (h)) * HTB)
#define PG8_STAGE(bufoff, gbase, voff) do { _Pragma("unroll") for (int _i = 0; _i < 2; ++_i) \
        __builtin_amdgcn_global_load_lds((const unsigned*)((const char*)(gbase) + (voff)[_i]), (PG8_LAS unsigned*)(lds + (bufoff) + ldsw + _i * 8192), 16, 0, 0); } while (0)
#define PG8_LDA(dst, b, h) do { _Pragma("unroll") for (int m = 0; m < 4; ++m) _Pragma("unroll") for (int k = 0; k < 2; ++k) dst[m][k] = *(const PG8_LAS bf16x8*)(lds + PG8_SA(b, h) + aoff + m * 2048 + k * 1024); } while (0)
#define PG8_LDB(dst, b, h) do { _Pragma("unroll") for (int n = 0; n < 2; ++n) _Pragma("unroll") for (int k = 0; k < 2; ++k) dst[n][k] = *(const PG8_LAS bf16x8*)(lds + PG8_SB(b, h) + boff + n * 2048 + k * 1024); } while (0)
#define PG8_MMA(ai, bj, At, Bt) do { __builtin_amdgcn_s_setprio(1); _Pragma("unroll") for (int m = 0; m < 4; ++m) _Pragma("unroll") for (int n = 0; n < 2; ++n) _Pragma("unroll") for (int k = 0; k < 2; ++k) \
        acc[ai][bj][m][n] = __builtin_amdgcn_mfma_f32_16x16x32_bf16(Bt[n][k], At[m][k], acc[ai][bj][m][n], 0, 0, 0); __builtin_amdgcn_s_setprio(0); } while (0)
#define PG8_WAIT_V(n) asm volatile("s_waitcnt vmcnt(" #n ")" ::: "memory")
#define PG8_WAIT_L(n) asm volatile("s_waitcnt lgkmcnt(" #n ")" ::: "memory")
#define PG8_BAR __builtin_amdgcn_s_barrier()
#define PG8_SCHED __builtin_amdgcn_sched_barrier(0)
    Unit cur, nxt; int ui = 0;
    if (!S.next(0, cur)) return;
    f32x4 acc[2][2][4][2];
#pragma unroll
    for (int a = 0; a < 2; ++a)
#pragma unroll
        for (int b = 0; b < 2; ++b)
#pragma unroll
            for (int m = 0; m < 4; ++m)
#pragma unroll
                for (int n = 0; n < 2; ++n) acc[a][b][m][n] = (f32x4){0.f, 0.f, 0.f, 0.f};
    bf16x8 At[4][2], B0[2][2], B1[2][2];
    const char* cA = (const char*)g.A + (size_t)cur.pm * tstep; const char* cB = (const char*)g.Bt + (size_t)cur.pb * tstep;
    S.a_ready(cur);
    if constexpr (SP2) {
        PG8_STAGE(PG8_SB(0, 0), cB, voffB); PG8_STAGE(PG8_SB(0, 1), cB + hstep, voffB); PG8_STAGE(PG8_SA(0, 0), cA, voffA); PG8_STAGE(PG8_SA(0, 1), cA + hstepA, voffA1);
        if (wr == 1) PG8_BAR;
        PG8_WAIT_V(2); PG8_BAR;
        PG8_STAGE(PG8_SB(1, 0), cB + kstep, voffB); PG8_STAGE(PG8_SA(1, 0), cA + kstep, voffA); PG8_STAGE(PG8_SB(1, 1), cB + hstep + kstep, voffB);
        PG8_WAIT_V(6); PG8_BAR;
    } else {
        PG8_STAGE(PG8_SB(0, 0), cB, voffB); PG8_STAGE(PG8_SA(0, 0), cA, voffA); PG8_STAGE(PG8_SB(0, 1), cB + hstep, voffB); PG8_STAGE(PG8_SA(0, 1), cA + hstepA, voffA1);
        if (wr == 1) PG8_BAR;
        PG8_WAIT_V(4); PG8_BAR;
        PG8_STAGE(PG8_SB(1, 0), cB + kstep, voffB); PG8_STAGE(PG8_SA(1, 0), cA + kstep, voffA); PG8_STAGE(PG8_SB(1, 1), cB + hstep + kstep, voffB);
        PG8_WAIT_V(6); PG8_BAR;
    }
    for (;;) {
        const bool has_next = S.next(ui + 1, nxt);
        const char* nA = has_next ? (const char*)g.A + (size_t)nxt.pm * tstep : cA; const char* nB = has_next ? (const char*)g.Bt + (size_t)nxt.pb * tstep : cB;
#pragma unroll 1
        for (int t = 0; t < nt; t += 2) {
            const bool last = (t == nt - 2);
            const char* a1 = cA + (size_t)(t + 1) * kstep;
            const char* a2 = last ? nA : cA + (size_t)(t + 2) * kstep; const char* b2 = last ? nB : cB + (size_t)(t + 2) * kstep;
            const char* a3 = a2 + kstep; const char* b3 = b2 + kstep;
            if (last && has_next) S.a_ready(nxt);
            if constexpr (SP2) {
            PG8_LDB(B0, 0, 0); PG8_LDB(B1, 0, 1); PG8_SCHED; PG8_LDA(At, 0, 0); PG8_STAGE(PG8_SA(1, 1), a1 + hstepA, voffA1);
            PG8_WAIT_V(8); PG8_WAIT_L(0); PG8_BAR; PG8_MMA(0, 0, At, B0); PG8_MMA(0, 1, At, B1); PG8_BAR; PG8_SCHED;
            PG8_LDA(At, 0, 1); PG8_STAGE(PG8_SB(0, 0), b2, voffB); PG8_STAGE(PG8_SB(0, 1), b2 + hstep, voffB); PG8_STAGE(PG8_SA(0, 0), a2, voffA);
            PG8_WAIT_V(8); PG8_WAIT_L(0); PG8_BAR; PG8_MMA(1, 0, At, B0); PG8_MMA(1, 1, At, B1); PG8_BAR; PG8_SCHED;
            PG8_LDB(B0, 1, 0); PG8_LDB(B1, 1, 1); PG8_SCHED; PG8_LDA(At, 1, 0); PG8_STAGE(PG8_SA(0, 1), a2 + hstepA, voffA1);
            PG8_WAIT_V(8); PG8_WAIT_L(0); PG8_BAR; PG8_MMA(0, 0, At, B0); PG8_MMA(0, 1, At, B1); PG8_BAR; PG8_SCHED;
            PG8_LDA(At, 1, 1); PG8_STAGE(PG8_SB(1, 0), b3, voffB); PG8_STAGE(PG8_SB(1, 1), b3 + hstep, voffB); PG8_STAGE(PG8_SA(1, 0), a3, voffA);
            PG8_WAIT_V(8); PG8_WAIT_L(0); PG8_BAR; PG8_MMA(1, 0, At, B0); PG8_MMA(1, 1, At, B1); PG8_BAR; PG8_SCHED;
            } else {
            PG8_LDB(B0, 0, 0); PG8_SCHED; PG8_LDA(At, 0, 0); PG8_STAGE(PG8_SA(1, 1), a1 + hstepA, voffA1);
            PG8_WAIT_L(8); PG8_BAR; PG8_WAIT_L(0); PG8_MMA(0, 0, At, B0); PG8_BAR; PG8_SCHED;
            PG8_LDB(B1, 0, 1); PG8_STAGE(PG8_SB(0, 0), b2, voffB);
            PG8_BAR; PG8_WAIT_L(0); PG8_MMA(0, 1, At, B1); PG8_BAR;
            PG8_LDA(At, 0, 1); PG8_STAGE(PG8_SA(0, 0), a2, voffA);
            PG8_BAR; PG8_WAIT_L(0); PG8_MMA(1, 0, At, B0); PG8_BAR; PG8_SCHED;
            PG8_STAGE(PG8_SB(0, 1), b2 + hstep, voffB);
            PG8_WAIT_V(6); PG8_BAR; PG8_MMA(1, 1, At, B1); PG8_BAR;
            PG8_LDB(B0, 1, 0); PG8_SCHED; PG8_LDA(At, 1, 0); PG8_STAGE(PG8_SA(0, 1), a2 + hstepA, voffA1);
            PG8_WAIT_L(8); PG8_BAR; PG8_WAIT_L(0); PG8_MMA(0, 0, At, B0); PG8_BAR; PG8_SCHED;
            PG8_LDB(B1, 1, 1); PG8_STAGE(PG8_SB(1, 0), b3, voffB);
            PG8_BAR; PG8_WAIT_L(0); PG8_MMA(0, 1, At, B1); PG8_BAR;
            PG8_LDA(At, 1, 1); PG8_STAGE(PG8_SA(1, 0), a3, voffA);
            PG8_BAR; PG8_WAIT_L(0); PG8_MMA(1, 0, At, B0); PG8_BAR; PG8_SCHED;
            PG8_STAGE(PG8_SB(1, 1), b3 + hstep, voffB);
            PG8_WAIT_V(6); PG8_BAR; PG8_MMA(1, 1, At, B1); PG8_BAR;
            }
        }
        if constexpr (ALIGN_EPI) { if (wr == 0) PG8_BAR; }
        if constexpr (!Epi::AFTER_DRAIN) { E(acc, cur, wr, wc, fr, fq); S.done(cur); }
        if (!has_next) break;
#pragma unroll
        for (int a = 0; a < 2; ++a)
#pragma unroll
            for (int b = 0; b < 2; ++b)
#pragma unroll
                for (int m = 0; m < 4; ++m)
#pragma unroll
                    for (int n = 0; n < 2; ++n) acc[a][b][m][n] = (f32x4){0.f, 0.f, 0.f, 0.f};
        cur = nxt; cA = nA; cB = nB; ++ui;
        if constexpr (ALIGN_EPI) { if (wr == 1) PG8_BAR; }
    }
    PG8_WAIT_V(0);
    if constexpr (!ALIGN_EPI) { if (wr == 0) PG8_BAR; }
    PG8_BAR;
    if constexpr (Epi::AFTER_DRAIN) { E.fused(acc, cur, wr, wc, fr, fq, lds, wid, lane); S.done(cur); }
#undef PG8_SA
#undef PG8_SB
#undef PG8_STAGE
#undef PG8_LDA
#undef PG8_LDB
#undef PG8_MMA
#undef PG8_WAIT_V
#undef PG8_WAIT_L
#undef PG8_BAR
#undef PG8_SCHED
}
}

constexpr int BATCH = 2, SEQ = 8192, DM = 1024, M = BATCH * SEQ;
constexpr int INW = 2312, NPROJ = 2304;
constexpr int C_Q = 0, C_K = 512, C_V = 640, C_Z = 768, C_XBC = 1280;
constexpr int NEXP = 32, DEXP = 256, TOKCAP = 16384;
constexpr int MODW = 6 * DM;
constexpr float EPS = 1e-6f;
constexpr int NWAVES = 8;

constexpr size_t MiB = 1u << 20;
constexpr size_t WS_CTL = 0, CTL_ZERO_BYTES = 64 * 1024;
constexpr size_t WS_MODP = 1 * MiB;
constexpr size_t WS_MOD = WS_MODP + 768 * 1024;
constexpr size_t WS_ROPE = 2 * MiB;
constexpr size_t WS_DTRAW = 3 * MiB;
constexpr size_t WS_CHDEC = 3 * MiB + 512 * 1024;
constexpr size_t WS_CW = 4 * MiB;
constexpr size_t WS_WRT = 4 * MiB + 512 * 1024;
constexpr size_t WS_WIN = 6 * MiB;
constexpr size_t WS_WOUT = 11 * MiB;
constexpr size_t WS_WGU = 13 * MiB;
constexpr size_t WS_WD = 45 * MiB;
constexpr size_t WS_XN = 61 * MiB;
constexpr size_t WS_PROJ = 93 * MiB;
constexpr size_t WS_ACT = 93 * MiB;
constexpr size_t WS_Y = 113 * MiB;
constexpr size_t WS_SLOT = 5 * MiB;
constexpr size_t WS_STATES = 165 * MiB;
constexpr size_t WS_PREV = 197 * MiB;
constexpr size_t WS_MIX = 213 * MiB;
constexpr size_t WS_TOK = 245 * MiB;
constexpr size_t WS_END = 249 * MiB;
constexpr int CW_TMO = 0, CW_CODE = 1, CW_BAR = 4096, CW_CNT = 8192;

constexpr int RING_BYTES = 131072;
constexpr int LDSCTL_OFF = 162816, MISC_OFF = LDSCTL_OFF + 320;
constexpr int LDS_BYTES = 163840;

#define GAS __attribute__((address_space(1)))
#define LAS __attribute__((address_space(3)))
typedef unsigned short bf16;
typedef unsigned v4u __attribute__((ext_vector_type(4)));
typedef float f32x4 __attribute__((ext_vector_type(4)));
typedef short bf16x8 __attribute__((ext_vector_type(8)));
typedef GAS unsigned gu32;
typedef GAS unsigned long long gu64;
#define RLX_AGENT __ATOMIC_RELAXED, __HIP_MEMORY_SCOPE_AGENT
#define LDS_WAIT() asm volatile("s_waitcnt lgkmcnt(0)" ::: "memory")
#define VM_WAIT() asm volatile("s_waitcnt vmcnt(0)" ::: "memory")
__device__ __forceinline__ unsigned long long rt() { return __builtin_amdgcn_s_memrealtime(); }
__device__ __forceinline__ unsigned f2bf(float f) { unsigned u = __builtin_bit_cast(unsigned, f); return (u + 0x7fffu + ((u >> 16) & 1u)) >> 16; }
__device__ __forceinline__ unsigned pk2(float lo, float hi) { return f2bf(lo) | (f2bf(hi) << 16); }

#define XB_TMO      128
#define XB_XCNT(j)  (256  + 64 * (j))
#define XB_XSUB(j)  (1280 + 64 * (j))
#define XB_XGEN(j)  (2304 + 64 * (j))
#define XB_TOP      3328
#define XB_TOPGEN   3392
#define XCD_BAR_WORDS 3456
#define XB_SPIN_CAP (1u << 18)

__device__ __forceinline__ unsigned xb_ld(unsigned* p)              { return __hip_atomic_load(p, __ATOMIC_RELAXED, __HIP_MEMORY_SCOPE_AGENT); }
__device__ __forceinline__ unsigned xb_add(unsigned* p, unsigned v) { return __hip_atomic_fetch_add(p, v, __ATOMIC_RELAXED, __HIP_MEMORY_SCOPE_AGENT); }
__device__ __forceinline__ unsigned xb_xcc_id() { return (unsigned)__builtin_amdgcn_s_getreg((3 << 11) | 20) & 0xFu; }
#define XB_SPIN(cond, bar) do { unsigned _sp = 0; while (cond) { __builtin_amdgcn_s_sleep(1); \
    if ((++_sp & 255u) == 0u) { if (xb_ld(&(bar)[XB_TMO])) break; if (_sp > XB_SPIN_CAP) { atomicAdd(&(bar)[XB_TMO], 1u); break; } } } } while (0)

struct XcdBarrier {
    unsigned* bar; unsigned x;
    volatile LAS unsigned* st;
};

__device__ __forceinline__ XcdBarrier xcd_barrier_post(unsigned* bar, volatile LAS unsigned* st) {
    XcdBarrier b; b.bar = bar; b.x = xb_xcc_id(); b.st = st;
    if (threadIdx.x == 0) (void)xb_add(&bar[XB_XCNT(b.x)], 1u);
    return b;
}
__device__ __forceinline__ void xcd_barrier_complete(unsigned* bar, unsigned x, unsigned& nloc, unsigned& nx) {
    const unsigned G = gridDim.x * gridDim.y * gridDim.z;
    unsigned sum, cnt, mine, sp = 0u;
    for (;;) {
        sum = 0u; cnt = 0u; mine = 0u;
#pragma unroll
        for (unsigned j = 0; j < 16; ++j) { const unsigned c = xb_ld(&bar[XB_XCNT(j)]); sum += c; cnt += (c > 0u) ? 1u : 0u; mine = (j == x) ? c : mine; }
        if (sum == G) break;
        __builtin_amdgcn_s_sleep(1);
        if ((++sp & 255u) == 0u) { if (xb_ld(&bar[XB_TMO])) break; if (sp > XB_SPIN_CAP) { atomicAdd(&bar[XB_TMO], 1u); break; } }
    }
    nloc = mine > 0u ? mine : 1u; nx = cnt > 0u ? cnt : 1u;
}

__device__ __forceinline__ void xcd_barrier(const XcdBarrier& b) {
    asm volatile("s_waitcnt vmcnt(0)" ::: "memory");
    __syncthreads();
    if (threadIdx.x == 0) {
        unsigned* bar = b.bar;
        __builtin_amdgcn_s_waitcnt(0);
        unsigned nloc = b.st[0], nx = b.st[1];
        if (nloc == 0u) { xcd_barrier_complete(bar, b.x, nloc, nx); b.st[0] = nloc; b.st[1] = nx; }
        const unsigned old = xb_add(&bar[XB_XSUB(b.x)], 1u);
        const unsigned gen = old / nloc;
        if (old + 1u == (gen + 1u) * nloc) {
            __builtin_amdgcn_fence(__ATOMIC_RELEASE, "agent");
            asm volatile("s_waitcnt vmcnt(0)" ::: "memory");
            const unsigned og = xb_add(&bar[XB_TOP], 1u);
            const unsigned tg = og / nx;
            if (og + 1u == (tg + 1u) * nx) xb_add(&bar[XB_TOPGEN], 1u);
            else XB_SPIN(xb_ld(&bar[XB_TOPGEN]) == tg, bar);
            __builtin_amdgcn_fence(__ATOMIC_ACQUIRE, "agent");
            xb_add(&bar[XB_XGEN(b.x)], 1u);
            asm volatile("s_waitcnt vmcnt(0)" ::: "memory");
        } else {
            XB_SPIN(xb_ld(&bar[XB_XGEN(b.x)]) == gen, bar);
            __builtin_amdgcn_fence(__ATOMIC_ACQUIRE, "agent");
            asm volatile("s_waitcnt vmcnt(0)" ::: "memory");
        }
    }
    __syncthreads();
}

typedef unsigned v2u __attribute__((ext_vector_type(2)));
struct KArgs { const void* in[25]; float* out; unsigned char* ws; int ph_lo, ph_hi; };
struct Ctx {
    LAS unsigned char* lds;
    int tid, lane, wave, G, bid;
    const __attribute__((address_space(4))) KArgs* ka;
    float* out; unsigned char* ws; gu32* ctl;
};
__device__ __forceinline__ float wave_sum(float v) {
#pragma unroll
    for (int o = 1; o < 64; o <<= 1) v += __shfl_xor(v, o);
    return v;
}
__device__ __forceinline__ float bf_lo(unsigned u) { return __uint_as_float(u << 16); }
__device__ __forceinline__ float bf_hi(unsigned u) { return __uint_as_float(u & 0xffff0000u); }
__device__ __forceinline__ unsigned cvtpk(float lo, float hi) { return pg8::cvt_pk_bf16(lo, hi); }
__device__ __forceinline__ float silu(float v) { return pg8::silu_f(v); }
__device__ __forceinline__ f32x4 mfma16(bf16x8 a, bf16x8 b, f32x4 c) { return __builtin_amdgcn_mfma_f32_16x16x32_bf16(a, b, c, 0, 0, 0); }
__device__ __forceinline__ void unpack8(const v4u q, float (&f)[8]) { f[0] = bf_lo(q.x); f[1] = bf_hi(q.x); f[2] = bf_lo(q.y); f[3] = bf_hi(q.y); f[4] = bf_lo(q.z); f[5] = bf_hi(q.z); f[6] = bf_lo(q.w); f[7] = bf_hi(q.w); }
__device__ __forceinline__ v4u pack8(const float (&f)[8]) { v4u o; o.x = cvtpk(f[0], f[1]); o.y = cvtpk(f[2], f[3]); o.z = cvtpk(f[4], f[5]); o.w = cvtpk(f[6], f[7]); return o; }
__device__ __forceinline__ float softplus_f(float v) {
    if (v > 20.f) return v;
    const float e = __expf(v), u = 1.0f + e;
    return (u == 1.0f) ? e : __logf(u) * (e / (u - 1.0f));
}

__device__ __forceinline__ void transpose_item(const float* W, int ldw, int k0, int n0, bf16* WT, int K, int drow0, LAS float* scr, int lane) {
    f32x4 v[8];
#pragma unroll
    for (int i = 0; i < 8; ++i) v[i] = *(const GAS f32x4*)(W + (size_t)(k0 + 8 * i + (lane >> 3)) * ldw + n0 + 4 * (lane & 7));
#pragma unroll
    for (int i = 0; i < 8; ++i) { LAS float* s = scr + (8 * i + (lane >> 3)) * 33 + 4 * (lane & 7); s[0] = v[i].x; s[1] = v[i].y; s[2] = v[i].z; s[3] = v[i].w; }
    LDS_WAIT(); asm volatile("" ::: "memory");
    const int c = lane & 7;
#pragma unroll
    for (int j = 0; j < 4; ++j) { const int n = (lane >> 3) + 8 * j; const LAS float* s = scr + (8 * c) * 33 + n;
        v4u o; o.x = cvtpk(s[0 * 33], s[1 * 33]); o.y = cvtpk(s[2 * 33], s[3 * 33]); o.z = cvtpk(s[4 * 33], s[5 * 33]); o.w = cvtpk(s[6 * 33], s[7 * 33]);
        *(GAS v4u*)(WT + (size_t)(drow0 + n) * K + k0 + 8 * c) = o; }
    LDS_WAIT(); asm volatile("" ::: "memory");
}
__device__ __forceinline__ void p0_prologue(const Ctx& F) {
    LAS float* scr = (LAS float*)(F.lds + F.wave * 16384);
    const int gw = F.bid * NWAVES + F.wave, NGW = F.G * NWAVES, lane = F.lane;
    for (int it = NGW - 1 - gw; it < 96 * 16; it += NGW) {
        const int cg = it % 96, ks = it / 96, col = cg * 64 + lane;
        float a0 = 0.f, a1 = 0.f;
        const float* wp = ((const float*)F.ka->in[5]) + (size_t)(ks * 64) * MODW + col;
#pragma unroll 16
        for (int kk = 0; kk < 64; ++kk) { const int k = ks * 64 + kk; const float w = wp[(size_t)kk * MODW]; a0 += silu(((const float*)F.ka->in[1])[k]) * w; a1 += silu(((const float*)F.ka->in[1])[DM + k]) * w; }
        ((float*)(F.ws + WS_MODP))[(size_t)(ks * 2 + 0) * MODW + col] = a0; ((float*)(F.ws + WS_MODP))[(size_t)(ks * 2 + 1) * MODW + col] = a1;
    }
    constexpr int I_IN = 16 * 72, I_OUT = 16 * 32, NITEMS = I_IN + I_OUT;
    for (int it = gw; it < NITEMS; it += NGW) {
        int r = it;
        if (r < I_IN) { const int kb = r / 72, nb = r % 72; transpose_item(((const float*)F.ka->in[7]), INW, 64 * kb, 32 * nb, ((bf16*)(F.ws + WS_WIN)), DM, 32 * nb, scr, lane); continue; } r -= I_IN;
        { const int kb = r / 32, nb = r % 32; transpose_item(((const float*)F.ka->in[17]), DM, 64 * kb, 32 * nb, ((bf16*)(F.ws + WS_WOUT)), DM, 32 * nb, scr, lane); }
    }
    const int gt = F.bid * 512 + F.tid, NGT = F.G * 512;
    for (int idx = gt; idx < 48 * DM; idx += NGT) { const int n = idx >> 10, k = idx & 1023;
        const float v = n < 4 ? ((const float*)F.ka->in[18])[k * 4 + n] : (n < 36 ? ((const float*)F.ka->in[20])[k * 32 + (n - 4)] : 0.f); ((bf16*)(F.ws + WS_WRT))[idx] = (bf16)f2bf(v); }
    for (int idx = gt; idx < M * 8; idx += NGT) { const int tok = idx >> 3, i = idx & 7;
        const double invf[8] = {1.0, 0.19392274474868576, 0.03760603093086393, 0.007292664737217109, 0.001414213562373095, 0.0002742481756762073, 5.318295896944988e-05, 1.031338537721246e-05};
        double fsel = invf[0];
#pragma unroll
        for (int q = 1; q < 8; ++q) fsel = (i == q) ? invf[q] : fsel;
        const double rev = (double)((const int*)F.ka->in[2])[tok] * fsel * 0.15915494309189535; const float fr = (float)(rev - __builtin_rint(rev));
        ((float*)(F.ws + WS_ROPE))[(size_t)tok * 16 + i] = __builtin_amdgcn_cosf(fr); ((float*)(F.ws + WS_ROPE))[(size_t)tok * 16 + 8 + i] = __builtin_amdgcn_sinf(fr); }
}

__device__ __forceinline__ void moe_weight_items(const Ctx& F, int wv, int nwv) {
    LAS float* scr = (LAS float*)(F.lds + F.wave * 16384);
    const int lane = F.lane;
    constexpr int I_G = 32 * 16 * 8, I_D = 32 * 4 * 32, NITEMS = 2 * I_G + I_D;
    for (int it = wv; it < NITEMS; it += nwv) {
        int r = it;
        if (r < I_G) { const int e = r / 128, kb = (r % 128) / 8, nb = r % 8; transpose_item(((const float*)F.ka->in[22]) + (size_t)e * DM * DEXP, DEXP, 64 * kb, 32 * nb, ((bf16*)(F.ws + WS_WGU)), DM, e * 512 + (nb >> 2) * 256 + (nb & 3) * 32, scr, lane); continue; } r -= I_G;
        if (r < I_G) { const int e = r / 128, kb = (r % 128) / 8, nb = r % 8; transpose_item(((const float*)F.ka->in[23]) + (size_t)e * DM * DEXP, DEXP, 64 * kb, 32 * nb, ((bf16*)(F.ws + WS_WGU)), DM, e * 512 + (nb >> 2) * 256 + 128 + (nb & 3) * 32, scr, lane); continue; } r -= I_G;
        { const int e = r / 128, kb = (r % 128) / 32, nb = r % 32; transpose_item(((const float*)F.ka->in[24]) + (size_t)e * DEXP * DM, DM, 64 * kb, 32 * nb, ((bf16*)(F.ws + WS_WD)) + (size_t)e * DM * DEXP, DEXP, 32 * nb, scr, lane); }
    }
}

__device__ __forceinline__ float mod_at(const Ctx& F, int b, int j) { float s = ((const float*)F.ka->in[6])[j];
#pragma unroll
    for (int ks = 0; ks < 16; ++ks) s += ((float*)(F.ws + WS_MODP))[(size_t)(ks * 2 + b) * MODW + j];
    return s; }
__device__ __forceinline__ void p1_norm(const Ctx& F) {
    LAS float* g1s = (LAS float*)(F.lds); LAS float* sh1 = (LAS float*)(F.lds + 8192); LAS float* Wdt = (LAS float*)(F.lds + 16384);
    for (int idx = F.tid; idx < 2 * DM; idx += 512) { const int b = idx >> 10, k = idx & 1023; g1s[idx] = ((const float*)F.ka->in[3])[k] * (1.0f + mod_at(F, b, DM + k)); sh1[idx] = mod_at(F, b, k); }
    for (int idx = F.tid; idx < DM * 8; idx += 512) Wdt[idx] = ((const float*)F.ka->in[7])[(size_t)(idx >> 3) * INW + NPROJ + (idx & 7)];
    for (int idx = F.bid * 512 + F.tid; idx < 2 * MODW; idx += F.G * 512) { const int b = idx / MODW, j = idx % MODW; ((float*)(F.ws + WS_MOD))[idx] = mod_at(F, b, j); }
    __syncthreads();
    const int gw = F.bid * NWAVES + F.wave, NGW = F.G * NWAVES, lane = F.lane;
    for (int m0 = gw; m0 < M; m0 += 2 * NGW) {
        const bool hasB = (m0 + NGW) < M;
        f32x4 v[2][4];
#pragma unroll
        for (int q = 0; q < 2; ++q) { const int m = (q && hasB) ? m0 + NGW : m0; const GAS f32x4* xr = (const GAS f32x4*)(((const float*)F.ka->in[0]) + (size_t)m * DM) + lane;
#pragma unroll
            for (int j = 0; j < 4; ++j) v[q][j] = xr[64 * j]; }
#pragma unroll
        for (int q = 0; q < 2; ++q) { if (q == 1 && !hasB) break;
            const int m = q ? m0 + NGW : m0, b = m >= SEQ ? 1 : 0;
            float s = 0.f;
#pragma unroll
            for (int j = 0; j < 4; ++j) s += (v[q][j].x * v[q][j].x + v[q][j].y * v[q][j].y) + (v[q][j].z * v[q][j].z + v[q][j].w * v[q][j].w);
            const float rstd = rsqrtf(wave_sum(s) * (1.f / DM) + EPS);
            float dacc[8];
#pragma unroll
            for (int t = 0; t < 8; ++t) dacc[t] = 0.f;
            GAS v2u* o8 = (GAS v2u*)(((bf16*)(F.ws + WS_XN)) + (size_t)m * DM) + lane;
#pragma unroll
            for (int j = 0; j < 4; ++j) { const int k0 = 4 * lane + 256 * j;
                const f32x4 gg = *(const LAS f32x4*)(g1s + b * DM + k0), ss = *(const LAS f32x4*)(sh1 + b * DM + k0);
                const f32x4 h = v[q][j] * rstd * gg + ss;
                v2u o; o.x = cvtpk(h.x, h.y); o.y = cvtpk(h.z, h.w); o8[64 * j] = o;
#pragma unroll
                for (int i = 0; i < 4; ++i) { const f32x4 w0 = *(const LAS f32x4*)(Wdt + (k0 + i) * 8), w1 = *(const LAS f32x4*)(Wdt + (k0 + i) * 8 + 4); const float hv = h[i];
                    dacc[0] += hv * w0.x; dacc[1] += hv * w0.y; dacc[2] += hv * w0.z; dacc[3] += hv * w0.w; dacc[4] += hv * w1.x; dacc[5] += hv * w1.y; dacc[6] += hv * w1.z; dacc[7] += hv * w1.w; } }
#pragma unroll
            for (int t = 0; t < 8; ++t) dacc[t] = wave_sum(dacc[t]);
            if (lane == 0) { GAS f32x4* dp = (GAS f32x4*)(((float*)(F.ws + WS_DTRAW)) + (size_t)m * 8); dp[0] = (f32x4){dacc[0], dacc[1], dacc[2], dacc[3]}; dp[1] = (f32x4){dacc[4], dacc[5], dacc[6], dacc[7]}; }
        }
    }
}

__device__ __forceinline__ void attn_unit(const Ctx& F, int b, int blk, int kvh) {
    constexpr int KSTR = 144, VSTR = 528;
    LAS unsigned char* Ks = F.lds; LAS unsigned char* Vt = F.lds + 36864; LAS unsigned char* Qs = F.lds + 36864 + 33792;
    LAS float* nw = (LAS float*)(F.lds + 36864 + 33792 + 73728);
    int lane = F.lane; asm volatile("" : "+v"(lane));
    const int tid = F.wave * 64 + lane, w = F.wave, fr = lane & 15, g = lane >> 4;
    __syncthreads();
    if (tid < 128) nw[tid] = tid < 64 ? ((const float*)F.ka->in[14])[tid] : ((const float*)F.ka->in[15])[tid - 64];
    {
        const int kr = tid >> 1, half = tid & 1, tok = blk * 128 - 128 + kr;
        const size_t growk = (size_t)b * SEQ + (tok < 0 ? 0 : tok);
        const bf16* rowk = ((bf16*)(F.ws + WS_PROJ)) + growk * NPROJ;
        v4u kq[4], vq[4], qq[2][4]; f32x4 rk[4], rq[2][4];
#pragma unroll
        for (int i = 0; i < 4; ++i) { kq[i] = *(const GAS v4u*)(rowk + C_K + kvh * 64 + half * 32 + 8 * i); vq[i] = *(const GAS v4u*)(rowk + C_V + kvh * 64 + half * 32 + 8 * i); }
#pragma unroll
        for (int q = 0; q < 2; ++q) { const int R = kr + 256 * q, hl = R >> 7, qi = R & 127; const size_t growq = (size_t)b * SEQ + blk * 128 + qi;
            const bf16* rowq = ((bf16*)(F.ws + WS_PROJ)) + growq * NPROJ + C_Q + (kvh * 4 + hl) * 64 + half * 32;
#pragma unroll
            for (int i = 0; i < 4; ++i) qq[q][i] = *(const GAS v4u*)(rowq + 8 * i);
            const GAS f32x4* rp = (const GAS f32x4*)(((float*)(F.ws + WS_ROPE)) + growq * 16);
#pragma unroll
            for (int i = 0; i < 4; ++i) rq[q][i] = rp[i]; }
        {   const GAS f32x4* rp = (const GAS f32x4*)(((float*)(F.ws + WS_ROPE)) + growk * 16);
#pragma unroll
            for (int i = 0; i < 4; ++i) rk[i] = rp[i]; }
        if (tok < 0) {
#pragma unroll
            for (int i = 0; i < 4; ++i) { kq[i] = (v4u){0u, 0u, 0u, 0u}; vq[i] = (v4u){0u, 0u, 0u, 0u}; } }
        __syncthreads();
        {   float f[4][8]; float ssq = 0.f;
#pragma unroll
            for (int i = 0; i < 4; ++i) { unpack8(kq[i], f[i]);
#pragma unroll
                for (int j = 0; j < 8; ++j) ssq += f[i][j] * f[i][j]; }
            ssq += __shfl_xor(ssq, 1);
            const float rstd = rsqrtf(ssq * (1.f / 64.f) + EPS);
#pragma unroll
            for (int i = 0; i < 4; ++i)
#pragma unroll
                for (int j = 0; j < 8; ++j) f[i][j] *= rstd * nw[64 + half * 32 + 8 * i + j];
            if (half == 0) { const float cs[8] = {rk[0].x, rk[0].y, rk[0].z, rk[0].w, rk[1].x, rk[1].y, rk[1].z, rk[1].w}, sn[8] = {rk[2].x, rk[2].y, rk[2].z, rk[2].w, rk[3].x, rk[3].y, rk[3].z, rk[3].w};
#pragma unroll
                for (int j = 0; j < 8; ++j) { const float x1 = f[0][j], x2 = f[1][j]; f[0][j] = x1 * cs[j] - x2 * sn[j]; f[1][j] = x2 * cs[j] + x1 * sn[j]; } }
#pragma unroll
            for (int i = 0; i < 4; ++i) *(LAS v4u*)(Ks + kr * KSTR + half * 64 + i * 16) = pack8(f[i]); }
#pragma unroll
        for (int i = 0; i < 4; ++i) { const unsigned wv[4] = {vq[i].x, vq[i].y, vq[i].z, vq[i].w};
#pragma unroll
            for (int q = 0; q < 4; ++q) { const int d = half * 32 + 8 * i + 2 * q;
                *(LAS unsigned short*)(Vt + d * VSTR + kr * 2) = (unsigned short)(wv[q] & 0xffffu); *(LAS unsigned short*)(Vt + (d + 1) * VSTR + kr * 2) = (unsigned short)(wv[q] >> 16); } }
#pragma unroll
        for (int q = 0; q < 2; ++q) { const int R = kr + 256 * q;
            float f[4][8]; float ssq = 0.f;
#pragma unroll
            for (int i = 0; i < 4; ++i) { unpack8(qq[q][i], f[i]);
#pragma unroll
                for (int j = 0; j < 8; ++j) ssq += f[i][j] * f[i][j]; }
            ssq += __shfl_xor(ssq, 1);
            const float rstd = rsqrtf(ssq * (1.f / 64.f) + EPS) * 0.125f;
#pragma unroll
            for (int i = 0; i < 4; ++i)
#pragma unroll
                for (int j = 0; j < 8; ++j) f[i][j] *= rstd * nw[half * 32 + 8 * i + j];
            if (half == 0) { const float cs[8] = {rq[q][0].x, rq[q][0].y, rq[q][0].z, rq[q][0].w, rq[q][1].x, rq[q][1].y, rq[q][1].z, rq[q][1].w}, sn[8] = {rq[q][2].x, rq[q][2].y, rq[q][2].z, rq[q][2].w, rq[q][3].x, rq[q][3].y, rq[q][3].z, rq[q][3].w};
#pragma unroll
                for (int j = 0; j < 8; ++j) { const float x1 = f[0][j], x2 = f[1][j]; f[0][j] = x1 * cs[j] - x2 * sn[j]; f[1][j] = x2 * cs[j] + x1 * sn[j]; } }
#pragma unroll
            for (int i = 0; i < 4; ++i) *(LAS v4u*)(Qs + R * KSTR + half * 64 + i * 16) = pack8(f[i]); }
    }
    __syncthreads();
    const int hl = w >> 1, hq = kvh * 4 + hl, qb = 64 * (w & 1);
    const float sink = ((const float*)F.ka->in[16])[hq];
#pragma unroll 1
    for (int mt = 0; mt < 4; ++mt) {
        const int qi = qb + 16 * mt + fr; const size_t grow = (size_t)b * SEQ + blk * 128 + qi;
        const int kt0 = 4 * (w & 1) + mt;
        const LAS unsigned char* qp = Qs + (hl * 128 + qi) * KSTR + 16 * g;
        const bf16x8 qf0 = *(const LAS bf16x8*)qp, qf1 = *(const LAS bf16x8*)(qp + 64);
        f32x4 acc[9];
#pragma unroll
        for (int j = 0; j < 9; ++j) { acc[j] = (f32x4){0.f, 0.f, 0.f, 0.f};
            const LAS unsigned char* kp = Ks + (16 * (kt0 + j) + fr) * KSTR + 16 * g;
            acc[j] = mfma16(*(const LAS bf16x8*)kp, qf0, acc[j]); acc[j] = mfma16(*(const LAS bf16x8*)(kp + 64), qf1, acc[j]);
            if ((j & 3) == 3) __builtin_amdgcn_sched_barrier(0); }
        float mx = -INFINITY;
#pragma unroll
        for (int j = 0; j < 9; ++j)
#pragma unroll
            for (int i = 0; i < 4; ++i) { const int s = 16 * (kt0 + j) + 4 * g + i, diff = qi + 128 - s; const bool valid = diff >= 0 && diff < 128 && (blk > 0 || s >= 128);
                const float v = valid ? acc[j][i] : -INFINITY; acc[j][i] = v; mx = fmaxf(mx, v); }
        mx = fmaxf(mx, __shfl_xor(mx, 16)); mx = fmaxf(mx, __shfl_xor(mx, 32)); mx = fmaxf(mx, sink);
        float sum = 0.f;
#pragma unroll
        for (int j = 0; j < 9; ++j)
#pragma unroll
            for (int i = 0; i < 4; ++i) { const float p = __expf(acc[j][i] - mx); acc[j][i] = p; sum += p; }
        sum += __shfl_xor(sum, 16); sum += __shfl_xor(sum, 32); sum += __expf(sink - mx);
        const float inv = 1.0f / sum;
        f32x4 o[4];
#pragma unroll
        for (int dt = 0; dt < 4; ++dt) o[dt] = (f32x4){0.f, 0.f, 0.f, 0.f};
#pragma unroll
        for (int kk = 0; kk < 5; ++kk) {
            v4u pb; pb.x = cvtpk(acc[2 * kk][0], acc[2 * kk][1]); pb.y = cvtpk(acc[2 * kk][2], acc[2 * kk][3]);
            if (kk < 4) { pb.z = cvtpk(acc[2 * kk + 1][0], acc[2 * kk + 1][1]); pb.w = cvtpk(acc[2 * kk + 1][2], acc[2 * kk + 1][3]); } else { pb.z = 0u; pb.w = 0u; }
            const bf16x8 bfrag = __builtin_bit_cast(bf16x8, pb);
#pragma unroll
            for (int dt = 0; dt < 4; ++dt) { const LAS unsigned char* vp = Vt + (16 * dt + fr) * VSTR + (16 * (kt0 + 2 * kk) + 4 * g) * 2;
                const v2u lo = *(const LAS v2u*)vp; v2u hi = (v2u){0u, 0u}; if (kk < 4) hi = *(const LAS v2u*)(vp + 32);
                const v4u av = {lo.x, lo.y, hi.x, hi.y};
                o[dt] = mfma16(__builtin_bit_cast(bf16x8, av), bfrag, o[dt]); }
            __builtin_amdgcn_sched_barrier(0); }
        bf16* op = ((bf16*)(F.ws + WS_MIX)) + grow * DM + hq * 64 + 4 * g;
#pragma unroll
        for (int dt = 0; dt < 4; ++dt) { v2u ov; ov.x = cvtpk(o[dt][0] * inv, o[dt][1] * inv); ov.y = cvtpk(o[dt][2] * inv, o[dt][3] * inv); *(GAS v2u*)(op + 16 * dt) = ov; }
    }
}

__device__ __forceinline__ void ssd_dt_cumsum(const Ctx& F, int b, int c, int grp, LAS float* dts, LAS float* acs, bool write_chdec, int lane) {
    const int w = F.wave;
    if (w < 4) { const int h = grp * 4 + w; const float A = -__expf(((const float*)F.ka->in[11])[h]), bias = ((const float*)F.ka->in[10])[h];
        const size_t row0 = (size_t)b * SEQ + c * 128;
        const float d0 = softplus_f(((float*)(F.ws + WS_DTRAW))[(row0 + lane) * 8 + h] + bias), d1 = softplus_f(((float*)(F.ws + WS_DTRAW))[(row0 + 64 + lane) * 8 + h] + bias);
        float s0 = d0 * A, s1 = d1 * A;
#pragma unroll
        for (int o = 1; o < 64; o <<= 1) { const float t0 = __shfl_up(s0, o), t1 = __shfl_up(s1, o); if (lane >= o) { s0 += t0; s1 += t1; } }
        s1 += __shfl(s0, 63);
        dts[w * 128 + lane] = d0; dts[w * 128 + 64 + lane] = d1; acs[w * 128 + lane] = s0; acs[w * 128 + 64 + lane] = s1;
        if (write_chdec && lane == 63) ((float*)(F.ws + WS_CHDEC))[((size_t)b * 64 + c) * 8 + h] = __expf(s1);
    }
}
__device__ __forceinline__ void conv_row8(const v4u x0, const v4u x1, const v4u x2, const v4u x3, const float (&w)[4][8], const float (&bias)[8], float (&y)[8]) {
    float a[8], bq[8], cq[8], d[8]; unpack8(x0, a); unpack8(x1, bq); unpack8(x2, cq); unpack8(x3, d);
#pragma unroll
    for (int j = 0; j < 8; ++j) { const float v = bias[j] + w[0][j] * a[j] + w[1][j] * bq[j] + w[2][j] * cq[j] + w[3][j] * d[j]; y[j] = silu(v); }
}
struct ConvRegs { v4u xr[19]; f32x4 w[10]; };
template <int NOCT>
__device__ __forceinline__ void ssd_conv_issue(const Ctx& F, int b, int c, int grp, int tid, ConvRegs& R) {
    const int co = tid & 63, sg = tid >> 6;
    if (co < NOCT) {
        const int ch0 = co < 32 ? grp * 256 + co * 8 : (co < 48 ? 512 + grp * 128 + (co - 32) * 8 : 768 + grp * 128 + (co - 48) * 8);
        const int t0 = c * 128 + 16 * sg - 3;
#pragma unroll
        for (int r = 0; r < 19; ++r) { const int t = t0 + r; R.xr[r] = (t < 0) ? (v4u){0u, 0u, 0u, 0u} : *(const GAS v4u*)(((bf16*)(F.ws + WS_PROJ)) + ((size_t)b * SEQ + t) * NPROJ + C_XBC + ch0); }
#pragma unroll
        for (int k = 0; k < 4; ++k) { R.w[2 * k] = *(const GAS f32x4*)(((const float*)F.ka->in[8]) + k * 1024 + ch0); R.w[2 * k + 1] = *(const GAS f32x4*)(((const float*)F.ka->in[8]) + k * 1024 + ch0 + 4); }
        R.w[8] = *(const GAS f32x4*)(((const float*)F.ka->in[9]) + ch0); R.w[9] = *(const GAS f32x4*)(((const float*)F.ka->in[9]) + ch0 + 4);
    }
}
template <int NOCT, bool TRANSPOSED_B, bool SCALE_X>
__device__ __forceinline__ void ssd_conv_finish(int tid, const ConvRegs& R, const LAS float* dts, const LAS float* acs, LAS unsigned char* Bdst, LAS unsigned char* XT, LAS unsigned char* Cs) {
    const int co = tid & 63, sg = tid >> 6;
    if (co < NOCT) {
        float w[4][8], bias[8];
#pragma unroll
        for (int k = 0; k < 4; ++k) { w[k][0] = R.w[2 * k].x; w[k][1] = R.w[2 * k].y; w[k][2] = R.w[2 * k].z; w[k][3] = R.w[2 * k].w; w[k][4] = R.w[2 * k + 1].x; w[k][5] = R.w[2 * k + 1].y; w[k][6] = R.w[2 * k + 1].z; w[k][7] = R.w[2 * k + 1].w; }
        bias[0] = R.w[8].x; bias[1] = R.w[8].y; bias[2] = R.w[8].z; bias[3] = R.w[8].w; bias[4] = R.w[9].x; bias[5] = R.w[9].y; bias[6] = R.w[9].z; bias[7] = R.w[9].w;
        const int hh = co >> 3, p0 = (co & 7) * 8;
#pragma unroll
        for (int i = 0; i < 16; i += 2) {
            const int l = 16 * sg + i;
            float ya[8], yb[8]; conv_row8(R.xr[i], R.xr[i + 1], R.xr[i + 2], R.xr[i + 3], w, bias, ya); conv_row8(R.xr[i + 1], R.xr[i + 2], R.xr[i + 3], R.xr[i + 4], w, bias, yb);
            if (co < 32) {
                float sa = 1.0f, sb = 1.0f;
                if (SCALE_X) { const float ae = acs[hh * 128 + 127]; sa = dts[hh * 128 + l] * __expf(ae - acs[hh * 128 + l]); sb = dts[hh * 128 + l + 1] * __expf(ae - acs[hh * 128 + l + 1]); }
#pragma unroll
                for (int j = 0; j < 8; ++j) *(LAS unsigned*)(XT + ((hh * 64 + p0 + j) * 136 + l) * 2) = cvtpk(ya[j] * sa, yb[j] * sb);
            } else if (co < 48) {
                const int n0 = (co - 32) * 8;
                if (TRANSPOSED_B) {
#pragma unroll
                    for (int j = 0; j < 8; ++j) *(LAS unsigned*)(Bdst + ((n0 + j) * 136 + l) * 2) = cvtpk(ya[j], yb[j]);
                } else { *(LAS v4u*)(Bdst + (l * 136 + n0) * 2) = pack8(ya); *(LAS v4u*)(Bdst + ((l + 1) * 136 + n0) * 2) = pack8(yb); }
            } else { const int n0 = (co - 48) * 8; *(LAS v4u*)(Cs + (l * 136 + n0) * 2) = pack8(ya); *(LAS v4u*)(Cs + ((l + 1) * 136 + n0) * 2) = pack8(yb); }
        }
    }
}

__device__ __forceinline__ void ssd_states_unit(const Ctx& F, int b, int c, int grp) {
    LAS float* dts = (LAS float*)(F.lds); LAS float* acs = (LAS float*)(F.lds + 2048);
    LAS unsigned char* BT = F.lds + 4096; LAS unsigned char* XT = F.lds + 4096 + 34816;
    int lane = F.lane; asm volatile("" : "+v"(lane));
    const int w = F.wave, tid = w * 64 + lane, fr = lane & 15, g = lane >> 4;
    __syncthreads();
    {   ConvRegs R; ssd_conv_issue<48>(F, b, c, grp, tid, R);
        ssd_dt_cumsum(F, b, c, grp, dts, acs, true, lane);
        __syncthreads();
        ssd_conv_finish<48, true, true>(tid, R, dts, acs, BT, XT, nullptr); }
    __syncthreads();
    const int hh = w >> 1, nt0 = 4 * (w & 1), h = grp * 4 + hh;
    f32x4 acc[4][4];
#pragma unroll
    for (int a = 0; a < 4; ++a)
#pragma unroll
        for (int p = 0; p < 4; ++p) acc[a][p] = (f32x4){0.f, 0.f, 0.f, 0.f};
#pragma unroll
    for (int ks = 0; ks < 4; ++ks) {
        bf16x8 af[4], bfq[4];
#pragma unroll
        for (int a = 0; a < 4; ++a) af[a] = *(const LAS bf16x8*)(BT + ((16 * (nt0 + a) + fr) * 136 + 32 * ks + 8 * g) * 2);
#pragma unroll
        for (int p = 0; p < 4; ++p) bfq[p] = *(const LAS bf16x8*)(XT + ((hh * 64 + 16 * p + fr) * 136 + 32 * ks + 8 * g) * 2);
#pragma unroll
        for (int a = 0; a < 4; ++a)
#pragma unroll
            for (int p = 0; p < 4; ++p) acc[a][p] = mfma16(af[a], bfq[p], acc[a][p]);
    }
    float* sp = ((float*)(F.ws + WS_STATES)) + (((size_t)b * 64 + c) * 8 + h) * 64 * 128;
#pragma unroll
    for (int a = 0; a < 4; ++a)
#pragma unroll
        for (int p = 0; p < 4; ++p) *(GAS f32x4*)(sp + (size_t)(16 * p + fr) * 128 + 16 * (nt0 + a) + 4 * g) = acc[a][p];
}

__device__ __forceinline__ void ssd_scan(const Ctx& F) {
    for (int e = F.bid * 512 + F.tid; e < BATCH * 65536; e += F.G * 512) {
        const int b = e >> 16, rem = e & 65535, h = rem >> 13;
        float carry = 0.f;
        const float* sp = ((float*)(F.ws + WS_STATES)) + (size_t)b * 64 * 65536 + rem; bf16* pp = ((bf16*)(F.ws + WS_PREV)) + (size_t)b * 64 * 65536 + rem; const float* dp = ((float*)(F.ws + WS_CHDEC)) + (size_t)b * 64 * 8 + h;
#pragma unroll 8
        for (int c = 0; c < 64; ++c) { const float st = sp[(size_t)c * 65536], dec = dp[c * 8]; pp[(size_t)c * 65536] = (bf16)f2bf(carry); carry = carry * dec + st; }
    }
}

__device__ __forceinline__ void ssd_out_unit(const Ctx& F, int b, int c, int grp) {
    LAS float* dts = (LAS float*)(F.lds); LAS float* acs = (LAS float*)(F.lds + 2048);
    LAS unsigned char* Bs = F.lds + 4096; LAS unsigned char* XT = F.lds + 4096 + 34816; LAS unsigned char* Cs = F.lds + 4096 + 34816 + 69632;
    int lane = F.lane; asm volatile("" : "+v"(lane));
    const int w = F.wave, tid = w * 64 + lane, fr = lane & 15, g = lane >> 4;
    const int l = 16 * w + fr, t = c * 128 + l; const size_t grow = (size_t)b * SEQ + t;
    __syncthreads();
    {   ConvRegs R; ssd_conv_issue<64>(F, b, c, grp, tid, R);
        ssd_dt_cumsum(F, b, c, grp, dts, acs, false, lane);
        __syncthreads();
        ssd_conv_finish<64, false, false>(tid, R, dts, acs, Bs, XT, Cs); }
    LAS unsigned char* PVs = F.lds + 143360;
    v4u pn[2]; v2u zq[4];
    const bf16* pbase = ((bf16*)(F.ws + WS_PREV)) + (((size_t)b * 64 + c) * 8 + grp * 4) * 64 * 128;
#pragma unroll
    for (int q = 0; q < 2; ++q) pn[q] = *(const GAS v4u*)(pbase + (size_t)(tid * 2 + q) * 8);
#pragma unroll
    for (int pt = 0; pt < 4; ++pt) zq[pt] = *(const GAS v2u*)(((bf16*)(F.ws + WS_PROJ)) + grow * NPROJ + C_Z + (grp * 4) * 64 + 16 * pt + 4 * g);
#pragma unroll
    for (int q = 0; q < 2; ++q) { const int idx = tid * 2 + q; *(LAS v4u*)(PVs + (idx >> 4) * 272 + (idx & 15) * 16) = pn[q]; }
    __syncthreads();
    bf16x8 cf[4];
#pragma unroll
    for (int ks = 0; ks < 4; ++ks) cf[ks] = *(const LAS bf16x8*)(Cs + (l * 136 + 32 * ks + 8 * g) * 2);
    f32x4 cb[8];
#pragma unroll
    for (int st = 0; st < 8; ++st) { cb[st] = (f32x4){0.f, 0.f, 0.f, 0.f};
        if (st <= w) {
#pragma unroll
            for (int ks = 0; ks < 4; ++ks) cb[st] = mfma16(*(const LAS bf16x8*)(Bs + ((16 * st + fr) * 136 + 32 * ks + 8 * g) * 2), cf[ks], cb[st]); } }
    v2u yv[4][4]; float ysum = 0.f;
#pragma unroll
    for (int hh = 0; hh < 4; ++hh) { const int h = grp * 4 + hh;
        const float acl = acs[hh * 128 + l];
        f32x4 y[4];
#pragma unroll
        for (int pt = 0; pt < 4; ++pt) y[pt] = (f32x4){0.f, 0.f, 0.f, 0.f};
        if (hh < 3) {
#pragma unroll
            for (int q = 0; q < 2; ++q) pn[q] = *(const GAS v4u*)(pbase + (size_t)(hh + 1) * 64 * 128 + (size_t)(tid * 2 + q) * 8); }
#pragma unroll
        for (int ks = 0; ks < 4; ++ks)
#pragma unroll
            for (int pt = 0; pt < 4; ++pt) y[pt] = mfma16(*(const LAS bf16x8*)(PVs + (16 * pt + fr) * 272 + (32 * ks + 8 * g) * 2), cf[ks], y[pt]);
        if (hh < 3) { __syncthreads();
#pragma unroll
            for (int q = 0; q < 2; ++q) { const int idx = tid * 2 + q; *(LAS v4u*)(PVs + (idx >> 4) * 272 + (idx & 15) * 16) = pn[q]; } }
        const float eal = __expf(acl);
#pragma unroll
        for (int pt = 0; pt < 4; ++pt) y[pt] = y[pt] * eal;
#pragma unroll
        for (int kk = 0; kk < 4; ++kk) if (2 * kk <= w) {
            float mv[8];
#pragma unroll
            for (int q = 0; q < 2; ++q) { const int st = 2 * kk + q;
                const f32x4 as4 = *(const LAS f32x4*)(acs + hh * 128 + 16 * st + 4 * g), ds4 = *(const LAS f32x4*)(dts + hh * 128 + 16 * st + 4 * g);
#pragma unroll
                for (int i = 0; i < 4; ++i) { const bool ok = (st < w) || (st == w && (4 * g + i) <= fr); mv[4 * q + i] = ok ? cb[st][i] * __expf(acl - as4[i]) * ds4[i] : 0.f; } }
            const bf16x8 bfrag = __builtin_bit_cast(bf16x8, pack8(mv));
#pragma unroll
            for (int pt = 0; pt < 4; ++pt) { const LAS unsigned char* xp = XT + ((hh * 64 + 16 * pt + fr) * 136 + 32 * kk + 4 * g) * 2;
                const v2u lo = *(const LAS v2u*)xp, hi = *(const LAS v2u*)(xp + 32); const v4u av = {lo.x, lo.y, hi.x, hi.y};
                y[pt] = mfma16(__builtin_bit_cast(bf16x8, av), bfrag, y[pt]); } }
        const float dsk = ((const float*)F.ka->in[12])[h];
#pragma unroll
        for (int pt = 0; pt < 4; ++pt) {
            const float z[4] = {bf_lo(zq[pt].x), bf_hi(zq[pt].x), bf_lo(zq[pt].y), bf_hi(zq[pt].y)};
            float vv[4];
#pragma unroll
            for (int i = 0; i < 4; ++i) { const int p = 16 * pt + 4 * g + i; const float xs = __uint_as_float((unsigned)(*(const LAS unsigned short*)(XT + ((hh * 64 + p) * 136 + l) * 2)) << 16);
                const float v = (y[pt][i] + dsk * xs) * silu(z[i]); vv[i] = v; ysum += v * v; }
            yv[hh][pt].x = cvtpk(vv[0], vv[1]); yv[hh][pt].y = cvtpk(vv[2], vv[3]); }
        __builtin_amdgcn_sched_barrier(0);
        if (hh < 3) {
#pragma unroll
            for (int pt = 0; pt < 4; ++pt) zq[pt] = *(const GAS v2u*)(((bf16*)(F.ws + WS_PROJ)) + grow * NPROJ + C_Z + (h + 1) * 64 + 16 * pt + 4 * g);
            __syncthreads(); }
    }
    ysum += __shfl_xor(ysum, 16); ysum += __shfl_xor(ysum, 32);
    const float rstd = rsqrtf(ysum * (1.f / 256.f) + EPS);
#pragma unroll
    for (int hh = 0; hh < 4; ++hh)
#pragma unroll
        for (int pt = 0; pt < 4; ++pt) { const int ch = (grp * 4 + hh) * 64 + 16 * pt + 4 * g; const f32x4 nw = *(const GAS f32x4*)(((const float*)F.ka->in[13]) + ch);
            v2u ov; ov.x = cvtpk(bf_lo(yv[hh][pt].x) * rstd * nw.x, bf_hi(yv[hh][pt].x) * rstd * nw.y); ov.y = cvtpk(bf_lo(yv[hh][pt].y) * rstd * nw.z, bf_hi(yv[hh][pt].y) * rstd * nw.w);
            *(GAS v2u*)(((bf16*)(F.ws + WS_MIX)) + grow * DM + 512 + ch) = ov; }
}

__device__ __forceinline__ void p7_router(const Ctx& F) {
    LAS float* g2s = (LAS float*)(F.lds); LAS float* sh2 = (LAS float*)(F.lds + 8192);
    LAS float* pssq = (LAS float*)(F.lds + 16384);
    LAS float* plog = (LAS float*)(F.lds + 17408);
    LAS float* lg = (LAS float*)(F.lds + 17408 + 49152);
    for (int idx = F.tid; idx < 2 * DM; idx += 512) { const int b = idx >> 10, k = idx & 1023; g2s[idx] = ((const float*)F.ka->in[4])[k] * (1.0f + ((float*)(F.ws + WS_MOD))[b * MODW + 4 * DM + k]); sh2[idx] = ((float*)(F.ws + WS_MOD))[b * MODW + 3 * DM + k]; }
    __syncthreads();
    const int lane = F.lane, w = F.wave, fr = lane & 15, g = lane >> 4, kw = 128 * w + 8 * g;
    bf16x8 wf[3][4];
#pragma unroll
    for (int nt = 0; nt < 3; ++nt)
#pragma unroll
        for (int ks = 0; ks < 4; ++ks) wf[nt][ks] = *(const GAS bf16x8*)(((bf16*)(F.ws + WS_WRT)) + (size_t)(16 * nt + fr) * DM + kw + 32 * ks);
    for (int it = F.bid; it < M / 32; it += F.G) {
        const int row0 = it * 32, b = row0 >= SEQ ? 1 : 0;
        f32x4 xa[2][4], xb[2][4];
#pragma unroll
        for (int mt = 0; mt < 2; ++mt)
#pragma unroll
            for (int ks = 0; ks < 4; ++ks) { const size_t ro = (size_t)(row0 + 16 * mt + fr); const float* xp = ((const float*)F.ka->in[0]) + ro * DM + kw + 32 * ks;
                const v4u dq = *(const GAS v4u*)((const bf16*)F.out + ro * (2 * DM) + DM + kw + 32 * ks);
                xa[mt][ks] = *(const GAS f32x4*)xp + (f32x4){bf_lo(dq.x), bf_hi(dq.x), bf_lo(dq.y), bf_hi(dq.y)}; xb[mt][ks] = *(const GAS f32x4*)(xp + 4) + (f32x4){bf_lo(dq.z), bf_hi(dq.z), bf_lo(dq.w), bf_hi(dq.w)}; }
#pragma unroll
        for (int mt = 0; mt < 2; ++mt) { float s = 0.f;
#pragma unroll
            for (int ks = 0; ks < 4; ++ks) { const f32x4 a = xa[mt][ks], c4 = xb[mt][ks]; s += (a.x * a.x + a.y * a.y) + (a.z * a.z + a.w * a.w) + (c4.x * c4.x + c4.y * c4.y) + (c4.z * c4.z + c4.w * c4.w); }
            s += __shfl_xor(s, 16); s += __shfl_xor(s, 32);
            if (g == 0) pssq[w * 32 + 16 * mt + fr] = s; }
        __syncthreads();
#pragma unroll
        for (int mt = 0; mt < 2; ++mt) { float s = 0.f;
#pragma unroll
            for (int q = 0; q < 8; ++q) s += pssq[q * 32 + 16 * mt + fr];
            const float rstd = rsqrtf(s * (1.f / DM) + EPS);
            f32x4 acc[3];
#pragma unroll
            for (int nt = 0; nt < 3; ++nt) acc[nt] = (f32x4){0.f, 0.f, 0.f, 0.f};
            bf16* hp = ((bf16*)(F.ws + WS_XN)) + (size_t)(row0 + 16 * mt + fr) * DM + kw;
#pragma unroll
            for (int ks = 0; ks < 4; ++ks) { const int k0 = kw + 32 * ks;
                const f32x4 ga = *(const LAS f32x4*)(g2s + b * DM + k0), gb = *(const LAS f32x4*)(g2s + b * DM + k0 + 4), sa = *(const LAS f32x4*)(sh2 + b * DM + k0), sb = *(const LAS f32x4*)(sh2 + b * DM + k0 + 4);
                const f32x4 ha = xa[mt][ks] * rstd * ga + sa, hb = xb[mt][ks] * rstd * gb + sb;
                v4u hq; hq.x = cvtpk(ha.x, ha.y); hq.y = cvtpk(ha.z, ha.w); hq.z = cvtpk(hb.x, hb.y); hq.w = cvtpk(hb.z, hb.w);
                *(GAS v4u*)(hp + 32 * ks) = hq;
                const bf16x8 hf = __builtin_bit_cast(bf16x8, hq);
#pragma unroll
                for (int nt = 0; nt < 3; ++nt) acc[nt] = mfma16(hf, wf[nt][ks], acc[nt]); }
#pragma unroll
            for (int nt = 0; nt < 3; ++nt)
#pragma unroll
                for (int i = 0; i < 4; ++i) plog[(w * 32 + 16 * mt + 4 * g + i) * 48 + 16 * nt + fr] = acc[nt][i]; }
        __syncthreads();
#pragma unroll
        for (int q = 0; q < 3; ++q) { const int idx = F.tid + 512 * q; float s = 0.f;
#pragma unroll
            for (int ww = 0; ww < 8; ++ww) s += plog[ww * 1536 + idx];
            lg[idx] = s; }
        __syncthreads();
        if (F.tid < 32) {
            const LAS float* lr = lg + F.tid * 48; const int token = row0 + F.tid;
            float gl[4]; int gi = 0;
#pragma unroll
            for (int j = 0; j < 4; ++j) gl[j] = lr[j] + ((const float*)F.ka->in[19])[j];
            float gm = gl[0];
#pragma unroll
            for (int j = 1; j < 4; ++j) if (gl[j] > gm) { gm = gl[j]; gi = j; }
            float gs = 0.f;
#pragma unroll
            for (int j = 0; j < 4; ++j) gs += __expf(gl[j] - gm);
            const float gp = 1.0f / gs;
            float l1 = -INFINITY, l2 = -INFINITY; int i1 = 0, i2 = 0;
            for (int j = 0; j < 8; ++j) { const float v = lr[4 + gi * 8 + j] + ((const float*)F.ka->in[21])[gi * 8 + j];
                if (v > l1) { l2 = l1; i2 = i1; l1 = v; i1 = j; } else if (v > l2) { l2 = v; i2 = j; } }
            const float e21 = __expf(l2 - l1), w1 = 1.0f / (1.0f + e21), w2 = e21 * w1;
            ((float*)(F.ws + WS_CW))[token * 2 + 0] = gp * w1; ((float*)(F.ws + WS_CW))[token * 2 + 1] = gp * w2;
            const int e1 = gi * 8 + i1, e2 = gi * 8 + i2;
            const unsigned p1 = __hip_atomic_fetch_add((unsigned*)(F.ctl + CW_CNT) + 64 * e1, 1u, __ATOMIC_RELAXED, __HIP_MEMORY_SCOPE_AGENT);
            const unsigned p2 = __hip_atomic_fetch_add((unsigned*)(F.ctl + CW_CNT) + 64 * e2, 1u, __ATOMIC_RELAXED, __HIP_MEMORY_SCOPE_AGENT);
            ((int*)(F.ws + WS_SLOT))[token * 2 + 0] = e1 * TOKCAP + (int)p1; ((int*)(F.ws + WS_SLOT))[token * 2 + 1] = e2 * TOKCAP + (int)p2;
            ((int*)(F.ws + WS_TOK))[(size_t)e1 * TOKCAP + p1] = token; ((int*)(F.ws + WS_TOK))[(size_t)e2 * TOKCAP + p2] = token;
        }
    }
}

__device__ __forceinline__ void moe_tiles(const Ctx& F, LAS int* tb, LAS int* cn) {
    __syncthreads();
    if (F.tid < 32) cn[F.tid] = (int)__hip_atomic_load((unsigned*)(F.ctl + CW_CNT) + 64 * F.tid, __ATOMIC_RELAXED, __HIP_MEMORY_SCOPE_AGENT);
    __syncthreads();
    if (F.tid == 0) { int s = 0; for (int i = 0; i < 32; ++i) { tb[i] = s; s += (cn[i] + 255) >> 8; } tb[32] = s; }
    __syncthreads();
}
__device__ __forceinline__ int moe_find(const LAS int* tb, int T) { int idx = 0;
#pragma unroll 1
    for (int i = 1; i < 32; ++i) idx = (tb[i] <= T) ? i : idx;
    return idx; }
__device__ __forceinline__ void moe_up(const Ctx& F) {
    LAS int* tb = (LAS int*)(F.lds + MISC_OFF + 128); LAS int* cn = tb + 48;
    moe_tiles(F, tb, cn);
    const int NT = tb[32];
    for (int u = F.bid; u < 2 * NT; u += F.G) {
        const int T = u >> 1, nt = u & 1, e = moe_find(tb, T), lt = T - tb[e];
        int nvalid = cn[e] - lt * 256; nvalid = nvalid > 256 ? 256 : nvalid;
        pg8::Gemm gm{((bf16*)(F.ws + WS_XN)), ((bf16*)(F.ws + WS_WGU)), 256, 256, DM, ((int*)(F.ws + WS_TOK)) + (size_t)e * TOKCAP + lt * 256, nvalid};
        pg8::SingleUnit S{0, 0, e * 2 + nt};
        pg8::EpiAct E{((bf16*)(F.ws + WS_ACT)) + (size_t)T * 256 * 256 + nt * 128};
        pg8::gemm_phase<pg8::EpiAct, pg8::SingleUnit, false, true, true>(F.lds, gm, S, E);
    }
}
struct MoeDownOrder {
    const LAS int* tb; int NT, G, c;
    __device__ __forceinline__ bool next(int i, pg8::Unit& u) const { const int L = i * G + c; if (L >= 4 * NT) return false;
        const int T = L >> 2, pn = L & 3; u.pm = T; u.pn = pn; u.pb = moe_find(tb, T) * 4 + pn; return true; }
    __device__ __forceinline__ void a_ready(const pg8::Unit&) const {}
    __device__ __forceinline__ void done(const pg8::Unit&) const {}
};
__device__ __forceinline__ void moe_down(const Ctx& F) {
    LAS int* tb = (LAS int*)(F.lds + MISC_OFF + 128); LAS int* cn = tb + 48;
    moe_tiles(F, tb, cn);
    pg8::Gemm gm{((bf16*)(F.ws + WS_ACT)), ((bf16*)(F.ws + WS_WD)), 256, 256, DEXP, nullptr, 0};
    MoeDownOrder S{tb, tb[32], F.G, F.bid};
    pg8::EpiBf16 E{((bf16*)(F.ws + WS_Y)), DM};
    pg8::gemm_phase<pg8::EpiBf16, MoeDownOrder, true, true, false>(F.lds, gm, S, E);
}
__device__ __forceinline__ void moe_combine(const Ctx& F) {
    LAS int* tb = (LAS int*)(F.lds + MISC_OFF + 128); LAS int* cn = tb + 48;
    moe_tiles(F, tb, cn);
    const int gw = F.bid * NWAVES + F.wave, NGW = F.G * NWAVES, lane = F.lane;
    const bf16* Y = (const bf16*)(F.ws + WS_Y);
    for (int m = gw; m < M; m += 2 * NGW) {
        const int mB = m + NGW; const bool hasB = mB < M; const int m1 = hasB ? mB : m;
        int sl[2][2]; float cwv[2][2]; size_t rr[2][2]; const float* gp[2]; float* op[2]; const float* xin[2];
#pragma unroll
        for (int q = 0; q < 2; ++q) { const int mm = q ? m1 : m;
            sl[q][0] = ((const int*)(F.ws + WS_SLOT))[mm * 2]; sl[q][1] = ((const int*)(F.ws + WS_SLOT))[mm * 2 + 1];
            cwv[q][0] = ((const float*)(F.ws + WS_CW))[mm * 2]; cwv[q][1] = ((const float*)(F.ws + WS_CW))[mm * 2 + 1];
            gp[q] = ((const float*)(F.ws + WS_MOD)) + (mm >= SEQ ? MODW : 0) + 5 * DM; op[q] = F.out + (size_t)mm * DM; xin[q] = ((const float*)F.ka->in[0]) + (size_t)mm * DM; }
#pragma unroll
        for (int q = 0; q < 2; ++q)
#pragma unroll
            for (int k = 0; k < 2; ++k) rr[q][k] = (size_t)tb[sl[q][k] >> 14] * 256 + (sl[q][k] & (TOKCAP - 1));
        v2u ya[2][4], yb[2][4]; f32x4 xv[2][4], gv[2][4];
#pragma unroll
        for (int q = 0; q < 2; ++q)
#pragma unroll
            for (int j = 0; j < 4; ++j) { const int col = 4 * lane + 256 * j;
                ya[q][j] = *(const GAS v2u*)(Y + rr[q][0] * DM + col); yb[q][j] = *(const GAS v2u*)(Y + rr[q][1] * DM + col);
                const v2u dq = *(const GAS v2u*)((const bf16*)op[q] + DM + col);
                xv[q][j] = *(const GAS f32x4*)(xin[q] + col) + (f32x4){bf_lo(dq.x), bf_hi(dq.x), bf_lo(dq.y), bf_hi(dq.y)}; gv[q][j] = *(const GAS f32x4*)(gp[q] + col); }
#pragma unroll
        for (int q = 0; q < 2; ++q) { if (q == 1 && !hasB) break;
            const float c0 = cwv[q][0], c1 = cwv[q][1];
#pragma unroll
            for (int j = 0; j < 4; ++j) { const int col = 4 * lane + 256 * j; const v2u y0 = ya[q][j], y1 = yb[q][j]; const f32x4 x4 = xv[q][j], g4 = gv[q][j];
                f32x4 o; o.x = x4.x + g4.x * (c0 * bf_lo(y0.x) + c1 * bf_lo(y1.x)); o.y = x4.y + g4.y * (c0 * bf_hi(y0.x) + c1 * bf_hi(y1.x));
                o.z = x4.z + g4.z * (c0 * bf_lo(y0.y) + c1 * bf_lo(y1.y)); o.w = x4.w + g4.w * (c0 * bf_hi(y0.y) + c1 * bf_hi(y1.y));
                *(GAS f32x4*)(op[q] + col) = o; } }
    }
}

constexpr int NPHASE = 11;
typedef KArgs Args;
__global__ void __launch_bounds__(NWAVES * 64, 2) hymba_fwd(Args args) {
    extern __shared__ __attribute__((aligned(16))) unsigned char lds_raw[];
    Ctx F;
    F.lds = (LAS unsigned char*)lds_raw;
    F.tid = threadIdx.x; F.lane = F.tid & 63; F.wave = __builtin_amdgcn_readfirstlane(F.tid >> 6); F.G = gridDim.x; F.bid = blockIdx.x;
    F.ka = (const __attribute__((address_space(4))) KArgs*)__builtin_amdgcn_kernarg_segment_ptr();
    F.out = args.out; F.ws = args.ws; F.ctl = (gu32*)(args.ws + WS_CTL);
    for (int u = F.tid; u < (LDS_BYTES - LDSCTL_OFF) / 4; u += NWAVES * 64) ((LAS unsigned*)(F.lds + LDSCTL_OFF))[u] = 0u;
    __syncthreads();
    const int lo = args.ph_lo, hi = args.ph_hi;
    const bool use_bar = (hi - lo) > 1;
    XcdBarrier bar; bar.bar = (unsigned*)(F.ctl + CW_BAR); bar.x = 0; bar.st = nullptr;
    if (use_bar) bar = xcd_barrier_post((unsigned*)(F.ctl + CW_BAR), (volatile LAS unsigned*)(F.lds + MISC_OFF) + 8);
#ifndef PH_MASK
#define PH_MASK 0x7ff
#endif
#define IN(k) (((PH_MASK >> (k)) & 1) && lo <= (k) && (k) < hi)
#define SEAM(k) do { if (IN(k) && IN((k) + 1)) xcd_barrier(bar); asm volatile("" : "+v"(F.tid), "+v"(F.lane), "+s"(F.ka)); } while (0)
    if (IN(0)) p0_prologue(F);
    SEAM(0);
    if (IN(1)) p1_norm(F);
    SEAM(1);
    if (IN(2)) { pg8::Gemm gm{((bf16*)(F.ws + WS_XN)), ((bf16*)(F.ws + WS_WIN)), M, NPROJ, DM, nullptr, 0}; pg8::StaticOrder S; S.init(M, NPROJ, F.G, F.bid); pg8::EpiBf16 E{((bf16*)(F.ws + WS_PROJ)), NPROJ};
        pg8::gemm_phase<pg8::EpiBf16, pg8::StaticOrder, true, true, false>(F.lds, gm, S, E);
        { const int nun = (M / 256) * (NPROJ / 256), full = nun / F.G, extra = nun - full * F.G;
          if (extra > 0 && extra < F.G) { if (F.bid >= extra) moe_weight_items(F, (F.bid - extra) * NWAVES + F.wave, (F.G - extra) * NWAVES); }
          else moe_weight_items(F, F.bid * NWAVES + F.wave, F.G * NWAVES); } }
    SEAM(2);
    if (IN(3)) {
#ifndef TEST_NO_ATTN
        for (int u = F.bid; u < 256; u += F.G) attn_unit(F, u >> 7, (u >> 1) & 63, u & 1);
#endif
#ifndef TEST_NO_STATES
        for (int u = F.bid; u < 256; u += F.G) ssd_states_unit(F, u >> 7, (u >> 1) & 63, u & 1);
#endif
    }
    SEAM(3);
    if (IN(4)) ssd_scan(F);
    SEAM(4);
    if (IN(5)) { for (int u = F.bid; u < 256; u += F.G) ssd_out_unit(F, u >> 7, (u >> 1) & 63, u & 1); }
    SEAM(5);
    if (IN(6)) { __syncthreads(); pg8::Gemm gm{((bf16*)(F.ws + WS_MIX)), ((bf16*)(F.ws + WS_WOUT)), M, DM, DM, nullptr, 0}; pg8::StaticOrder S; S.init(M, DM, F.G, F.bid); pg8::EpiGateBf16 E{(bf16*)F.out + DM, 2 * DM, ((float*)(F.ws + WS_MOD)) + 2 * DM, MODW, SEQ};
        pg8::gemm_phase<pg8::EpiGateBf16, pg8::StaticOrder, true, true, false>(F.lds, gm, S, E); }
    SEAM(6);
    if (IN(7)) p7_router(F);
    SEAM(7);
    if (IN(8)) moe_up(F);
    SEAM(8);
    if (IN(9)) moe_down(F);
    SEAM(9);
    if (IN(10)) moe_combine(F);
#undef IN
#undef SEAM
}

#ifndef N_LAUNCHES
#define N_LAUNCHES 1
#endif
#ifndef REPEAT_MASK
#define REPEAT_MASK 0
#endif
extern "C" void kernel_launch(void* const* d_in, const int* in_sizes, int n_in, void* d_out, int out_size, void* d_ws, size_t ws_size, hipStream_t stream) {
    static int grid = 0;
    if (grid == 0) {
        if (n_in != 25 || in_sizes[0] != M * DM || out_size != M * DM || ws_size < WS_END) { fprintf(stderr, "kernel_launch: unexpected shapes (n_in %d, in0 %d, out %d, ws %zu)\n", n_in, n_in > 0 ? in_sizes[0] : -1, out_size, ws_size); grid = -1; return; }
        int dev = 0, cus = 0;
        if (hipGetDevice(&dev) != hipSuccess || hipDeviceGetAttribute(&cus, hipDeviceAttributeMultiprocessorCount, dev) != hipSuccess) { grid = -1; return; }
        if (hipFuncSetAttribute((const void*)hymba_fwd, hipFuncAttributeMaxDynamicSharedMemorySize, LDS_BYTES) != hipSuccess) { fprintf(stderr, "kernel_launch: hipFuncSetAttribute failed\n"); grid = -1; return; }
        int per_cu = 0;
        if (hipOccupancyMaxActiveBlocksPerMultiprocessor(&per_cu, (const void*)hymba_fwd, NWAVES * 64, LDS_BYTES) != hipSuccess || per_cu < 1) fprintf(stderr, "kernel_launch: occupancy query reports %d\n", per_cu);
        (void)hipGetLastError();
        grid = cus;
    }
    if (grid < 0) return;
    if (hipMemsetAsync((char*)d_ws + WS_CTL, 0, CTL_ZERO_BYTES, stream) != hipSuccess) return;
    Args a{};
    for (int i = 0; i < 25; ++i) a.in[i] = d_in[i];
    a.out = (float*)d_out; a.ws = (unsigned char*)d_ws;
    if (N_LAUNCHES == 1) { a.ph_lo = 0; a.ph_hi = NPHASE; hipLaunchKernelGGL(hymba_fwd, dim3(grid), dim3(NWAVES * 64), LDS_BYTES, stream, a); }
    else { for (int p = 0; p < NPHASE; ++p) { a.ph_lo = p; a.ph_hi = p + 1; for (int r = 0; r < 1 + ((REPEAT_MASK >> p) & 1); ++r) hipLaunchKernelGGL(hymba_fwd, dim3(grid), dim3(NWAVES * 64), LDS_BYTES, stream, a); } }
}
```
